# Optimizing an MI355X kernel written in HIP

```python
import math
import jax
import jax.numpy as jnp
from jax import lax
import numpy as np

D_MODEL = 2048
BATCH = 8
SEQ = 2048
DEPTH = 2

GRID_W = 64
CTX_LEN = 256
EPS = 1e-6

MIX_A = D_MODEL // 2
CHUNK = 128
A_GROUPS = 8
A_GROUP_DIM = MIX_A // A_GROUPS
MIX_B = D_MODEL - MIX_A
B_HEAD = 64
B_HEADS = MIX_B // B_HEAD
DECAY_LORA = 64
AAA_LORA = 64
GATE_LORA = 160
B_WIDTH = 3 * MIX_B + DECAY_LORA + AAA_LORA + GATE_LORA
B_SPLITS = (MIX_B, 2 * MIX_B, 3 * MIX_B, 3 * MIX_B + DECAY_LORA, 3 * MIX_B + DECAY_LORA + AAA_LORA)
IN_EVEN = 2 * MIX_A + B_WIDTH
GN_EPS = B_HEAD * 1e-5

C_HEADS = 16
C_HEAD = D_MODEL // C_HEADS // 2
ROPE_AXIS = C_HEAD // 2
ROPE_THETA = 10000.0
Q_BLOCK = 128
SUBLN_EPS = 1e-5

D_FF = 5632
N_EXPERTS = 8
TOP_K = 2
D_EXPERT = 7168

kernel_name = 'hybrid_dit_gmlp_rwkv7_diffattn_moe'


def rmsnorm(x, g, eps=EPS):
    xf = x.astype(jnp.float32)
    y = xf * lax.rsqrt(jnp.mean(xf * xf, axis=-1, keepdims=True) + eps)
    return (y * g.astype(jnp.float32)).astype(x.dtype)


def ada(cond, w, b):
    m = (jax.nn.silu(cond) @ w + b).reshape(cond.shape[:-1] + (6, D_MODEL))
    if cond.ndim == 2:
        m = m[:, None]
    return tuple(m[..., i, :] for i in range(6))


def modulate(h, shift, scale):
    return h * (1.0 + scale) + shift


def swiglu(h, w1, w3, w2):
    return (jax.nn.silu(h @ w1) * (h @ w3)) @ w2


def lambda_init(layer):
    return 0.8 - 0.6 * math.exp(-0.3 * layer)


def chunk_sgu(z, norm_g, ws, bs):
    bsz, t, _ = z.shape
    u = jax.nn.gelu(z[..., :MIX_A])
    v = jax.nn.gelu(z[..., MIX_A:]).reshape(bsz, t // CHUNK, CHUNK, A_GROUPS, A_GROUP_DIM)
    v = rmsnorm(v, norm_g)
    s = jnp.einsum('gpq,bnqgc->bnpgc', ws, v) + bs.T[:, :, None]
    return u * s.reshape(bsz, t, MIX_A)


def centred_shift(z, w):
    zp = jnp.pad(z, ((0, 0), (1, 1), (0, 0)))
    return w[0] * zp[:, :-2] + w[1] * zp[:, 1:-1] + w[2] * zp[:, 2:]


def _wkv_step(S, inp):
    r, decay, k, v, kk, a = inp
    sk = jnp.einsum('bhvk,bhk->bhv', S, kk)
    S = S * decay[:, :, None, :] - sk[..., None] * (kk * a)[:, :, None, :] + v[..., None] * k[:, :, None, :]
    return S, jnp.einsum('bhvk,bhk->bhv', S, r)


def rwkv7_bidir(z_ctx, z_lat, shift_w, w0, w_up, a0, a_up, g_up, k_k, k_a, r_k, lnx_w, lnx_b):
    f32 = jnp.float32

    def features(z):
        bsz, t, _ = z.shape
        z = centred_shift(z, shift_w).astype(f32)
        r, k, v, wd, ad, gd = jnp.split(z, B_SPLITS, axis=-1)
        heads = lambda a: a.reshape(bsz, t, B_HEADS, B_HEAD)
        g = jax.nn.sigmoid(gd) @ g_up.astype(f32)
        kk = heads(k * k_k)
        kk = kk / jnp.maximum(jnp.sqrt(jnp.sum(kk * kk, axis=-1, keepdims=True)), 1e-12)
        dirs = []
        for d in range(2):
            wlog = -jax.nn.softplus(-(w0[d] + jnp.tanh(wd) @ w_up[d])) - 0.5
            a = jax.nn.sigmoid(a0[d] + ad @ a_up[d])
            kd = k * (1.0 + (a - 1.0) * k_a)
            dirs.append((heads(jnp.exp(-jnp.exp(wlog))), heads(a), heads(kd)))
        return heads(r), heads(v), kk, g, dirs

    def wkv(S0, r, v, kk, decay, a, kd, reverse):
        tm = lambda a_: jnp.moveaxis(a_, 1, 0)
        S, y = lax.scan(_wkv_step, S0, (tm(r), tm(decay), tm(kd), tm(v), tm(kk), tm(a)), reverse=reverse)
        return S, jnp.moveaxis(y, 0, 1)

    def readout(r, v, g, ys, kds):
        y = ys[0] + ys[1]
        mu = jnp.mean(y, axis=-1, keepdims=True)
        var = jnp.mean(jnp.square(y - mu), axis=-1, keepdims=True)
        yn = ((y - mu) * lax.rsqrt(var + GN_EPS)).reshape(g.shape)
        out = yn * lnx_w + lnx_b
        bonus = (jnp.sum(r * kds[0] * r_k, axis=-1, keepdims=True)
                 + jnp.sum(r * kds[1] * r_k, axis=-1, keepdims=True)) * v
        return (out + bonus.reshape(g.shape)) * g

    rc, vc, kkc, gc, dc = features(z_ctx)
    rl, vl, kkl, gl, dl = features(z_lat)
    S0 = jnp.zeros((z_lat.shape[0], B_HEADS, B_HEAD, B_HEAD), f32)
    yc, yl = [], []
    for d, rev in enumerate((False, True)):
        decay, a, kd = dc[d]
        S_ctx, y = wkv(S0, rc, vc, kkc, decay, a, kd, rev)
        yc.append(y)
        decay, a, kd = dl[d]
        _, y = wkv(S_ctx, rl, vl, kkl, decay, a, kd, rev)
        yl.append(y)
    out_c = readout(rc, vc, gc, yc, (dc[0][2], dc[1][2]))
    out_l = readout(rl, vl, gl, yl, (dl[0][2], dl[1][2]))
    return out_c, out_l


def axial_rope(n):
    rows = n // GRID_W
    row = jnp.broadcast_to(jnp.arange(rows, dtype=jnp.float32)[:, None], (rows, GRID_W)).reshape(-1)
    col = jnp.broadcast_to(jnp.arange(GRID_W, dtype=jnp.float32)[None, :], (rows, GRID_W)).reshape(-1)
    inv = ROPE_THETA ** (-jnp.arange(0, ROPE_AXIS, 2, dtype=jnp.float32) / ROPE_AXIS)
    ar = row[:, None] * inv
    ac = col[:, None] * inv
    ang = jnp.concatenate([ar, ar, ac, ac], axis=-1)
    return jnp.cos(ang), jnp.sin(ang)


def apply_rope(x, cos, sin):
    xs = x.reshape(x.shape[:-1] + (2, 2, ROPE_AXIS // 2))
    rot = jnp.stack([-xs[..., 1, :], xs[..., 0, :]], axis=-2).reshape(x.shape)
    cos = cos[None, :, None, None, :]
    sin = sin[None, :, None, None, :]
    return (x * cos + rot * sin).astype(x.dtype)


def diff_attention(h, hc, w_qkv, q_g, k_g, lq1, lk1, lq2, lk2, subln_g, w_out, lam_init):
    bsz, t, _ = h.shape
    f32 = jnp.float32
    q, k, v = jnp.split(h @ w_qkv, 3, axis=-1)
    kc, vc = jnp.split(hc @ w_qkv[:, D_MODEL:], 2, axis=-1)
    sub = lambda a: a.reshape(a.shape[:2] + (C_HEADS, 2, C_HEAD))
    cos, sin = axial_rope(t)
    q = apply_rope(rmsnorm(sub(q), q_g), cos, sin)
    k = apply_rope(rmsnorm(sub(k), k_g), cos, sin)
    kc = rmsnorm(sub(kc), k_g)
    keys = jnp.concatenate([kc, k], axis=1)
    vals = jnp.concatenate([vc, v], axis=1).reshape(bsz, -1, C_HEADS, 2 * C_HEAD).astype(f32)
    lam = (jnp.exp(jnp.sum(lq1 * lk1).astype(f32)) - jnp.exp(jnp.sum(lq2 * lk2).astype(f32)) + lam_init)
    scale = C_HEAD ** -0.5

    def block(qb):
        s = jnp.einsum('bqhid,bkhid->bhiqk', qb, keys, preferred_element_type=f32) * scale
        p = jax.nn.softmax(s, axis=-1)
        attn = p[:, :, 0] - lam * p[:, :, 1]
        return jnp.einsum('bhqk,bkhe->bqhe', attn, vals)

    qb = q.reshape(bsz, t // Q_BLOCK, Q_BLOCK, C_HEADS, 2, C_HEAD).transpose(1, 0, 2, 3, 4, 5)
    o = lax.map(block, qb).transpose(1, 0, 2, 3, 4).reshape(bsz, t, C_HEADS, 2 * C_HEAD)
    o = rmsnorm(o, subln_g, SUBLN_EPS) * (1.0 - lam_init)
    return o.reshape(bsz, t, D_MODEL).astype(h.dtype) @ w_out


def moe(h, router, w1, w3, w2):
    bsz, t, d = h.shape
    hf = h.reshape(-1, d)
    logits = (hf @ router).astype(jnp.float32)
    top_v, top_i = lax.top_k(logits, TOP_K)
    gates = jax.nn.softmax(top_v, axis=-1)
    combine = jnp.sum(jax.nn.one_hot(top_i, N_EXPERTS, dtype=jnp.float32) * gates[..., None], axis=1)
    out = jnp.zeros(hf.shape, jnp.float32)
    for e in range(N_EXPERTS):
        out = out + combine[:, e:e + 1] * swiglu(hf, w1[e], w3[e], w2[e])
    return out.reshape(bsz, t, d).astype(h.dtype)


def even_layer(x, xc, c, c_ctx, ada_w, ada_b, n1, n2, w_in, sgu_g, sgu_w, sgu_b, shift_w, w0, w_up, a0, a_up,
               g_up, k_k, k_a, r_k, lnx_w, lnx_b, w_out, f1, f3, f2):
    ml = ada(c, ada_w, ada_b)
    mc = ada(c_ctx, ada_w, ada_b)
    hl = modulate(rmsnorm(x, n1), ml[0], ml[1]) @ w_in
    hc = modulate(rmsnorm(xc, n1), mc[0], mc[1]) @ w_in
    a_l = chunk_sgu(hl[..., :2 * MIX_A], sgu_g, sgu_w, sgu_b)
    a_c = chunk_sgu(hc[..., :2 * MIX_A], sgu_g, sgu_w, sgu_b)
    b_c, b_l = rwkv7_bidir(hc[..., 2 * MIX_A:], hl[..., 2 * MIX_A:], shift_w, w0, w_up, a0, a_up, g_up,
                           k_k, k_a, r_k, lnx_w, lnx_b)
    x = x + (ml[2] * (jnp.concatenate([a_l, b_l.astype(a_l.dtype)], axis=-1) @ w_out)).astype(x.dtype)
    xc = xc + (mc[2] * (jnp.concatenate([a_c, b_c.astype(a_c.dtype)], axis=-1) @ w_out)).astype(xc.dtype)
    x = x + (ml[5] * swiglu(modulate(rmsnorm(x, n2), ml[3], ml[4]), f1, f3, f2)).astype(x.dtype)
    xc = xc + (mc[5] * swiglu(modulate(rmsnorm(xc, n2), mc[3], mc[4]), f1, f3, f2)).astype(xc.dtype)
    return x, xc


def odd_layer(x, xc, c, c_ctx, lam_init, ada_w, ada_b, n1, n2, w_qkv, q_g, k_g, lq1, lk1, lq2, lk2, subln_g,
              w_out, router, e1, e3, e2):
    ml = ada(c, ada_w, ada_b)
    mc = ada(c_ctx, ada_w, ada_b)
    hl = modulate(rmsnorm(x, n1), ml[0], ml[1])
    hc = modulate(rmsnorm(xc, n1), mc[0], mc[1])
    x = x + (ml[2] * diff_attention(hl, hc, w_qkv, q_g, k_g, lq1, lk1, lq2, lk2, subln_g, w_out, lam_init)).astype(x.dtype)
    x = x + (ml[5] * moe(modulate(rmsnorm(x, n2), ml[3], ml[4]), router, e1, e3, e2)).astype(x.dtype)
    return x


def setup_inputs(seed: int = 0) -> dict:
    key = jax.random.key(seed)
    ks = iter(jax.random.split(key, 64))
    f32 = jnp.float32
    D = D_MODEL

    def nrm(shape, scale):
        return jax.random.normal(next(ks), shape, f32) * scale

    def gain(shape):
        return 1.0 + nrm(shape, 0.02)

    inp = {}
    inp['x'] = nrm((BATCH, SEQ, D), 1.0)
    inp['c'] = nrm((BATCH, D), 1.0)
    inp['ctx'] = nrm((BATCH, CTX_LEN, D), 1.0)
    inp['c_ctx'] = nrm((D,), 1.0)
    inp['l0_ada_w'] = nrm((D, 6 * D), 0.5 * D ** -0.5)
    inp['l0_ada_b'] = nrm((6 * D,), 0.02)
    inp['l0_norm1_g'] = gain((D,))
    inp['l0_norm2_g'] = gain((D,))
    inp['l0_w_in'] = nrm((D, IN_EVEN), D ** -0.5)
    inp['l0_sgu_norm_g'] = gain((A_GROUPS, A_GROUP_DIM))
    inp['l0_sgu_w'] = nrm((A_GROUPS, CHUNK, CHUNK), CHUNK ** -0.5)
    inp['l0_sgu_b'] = 1.0 + nrm((A_GROUPS, CHUNK), 0.02)
    inp['l0_shift_w'] = jnp.array([0.25, 0.5, 0.25], f32)[:, None] + nrm((3, B_WIDTH), 0.05)
    inp['l0_w0'] = jax.random.uniform(next(ks), (2, MIX_B), f32, -5.0, 1.0)
    inp['l0_w_up'] = nrm((2, DECAY_LORA, MIX_B), 0.5 * DECAY_LORA ** -0.5)
    inp['l0_a0'] = nrm((2, MIX_B), 0.1)
    inp['l0_a_up'] = nrm((2, AAA_LORA, MIX_B), AAA_LORA ** -0.5)
    inp['l0_g_up'] = nrm((GATE_LORA, MIX_B), GATE_LORA ** -0.5)
    inp['l0_k_k'] = 0.85 + nrm((MIX_B,), 0.02)
    inp['l0_k_a'] = 1.0 + nrm((MIX_B,), 0.02)
    inp['l0_r_k'] = nrm((B_HEADS, B_HEAD), 0.1)
    inp['l0_lnx_w'] = gain((MIX_B,))
    inp['l0_lnx_b'] = nrm((MIX_B,), 0.02)
    inp['l0_w_out'] = nrm((D, D), D ** -0.5)
    inp['l0_ffn_w1'] = nrm((D, D_FF), D ** -0.5)
    inp['l0_ffn_w3'] = nrm((D, D_FF), D ** -0.5)
    inp['l0_ffn_w2'] = nrm((D_FF, D), D_FF ** -0.5)
    inp['l1_ada_w'] = nrm((D, 6 * D), 0.5 * D ** -0.5)
    inp['l1_ada_b'] = nrm((6 * D,), 0.02)
    inp['l1_norm1_g'] = gain((D,))
    inp['l1_norm2_g'] = gain((D,))
    inp['l1_w_qkv'] = nrm((D, 3 * D), D ** -0.5)
    inp['l1_q_norm_g'] = gain((C_HEAD,))
    inp['l1_k_norm_g'] = gain((C_HEAD,))
    inp['l1_lam_q1'] = nrm((C_HEAD,), 0.1)
    inp['l1_lam_k1'] = nrm((C_HEAD,), 0.1)
    inp['l1_lam_q2'] = nrm((C_HEAD,), 0.1)
    inp['l1_lam_k2'] = nrm((C_HEAD,), 0.1)
    inp['l1_subln_g'] = gain((2 * C_HEAD,))
    inp['l1_w_out'] = nrm((D, D), D ** -0.5)
    inp['l1_router'] = nrm((D, N_EXPERTS), D ** -0.5)
    inp['l1_exp_w1'] = nrm((N_EXPERTS, D, D_EXPERT), D ** -0.5)
    inp['l1_exp_w3'] = nrm((N_EXPERTS, D, D_EXPERT), D ** -0.5)
    inp['l1_exp_w2'] = nrm((N_EXPERTS, D_EXPERT, D), D_EXPERT ** -0.5)
    return inp


def reference(x, c, ctx, c_ctx,
              l0_ada_w, l0_ada_b, l0_norm1_g, l0_norm2_g, l0_w_in, l0_sgu_norm_g, l0_sgu_w, l0_sgu_b,
              l0_shift_w, l0_w0, l0_w_up, l0_a0, l0_a_up, l0_g_up, l0_k_k, l0_k_a, l0_r_k, l0_lnx_w, l0_lnx_b,
              l0_w_out, l0_ffn_w1, l0_ffn_w3, l0_ffn_w2,
              l1_ada_w, l1_ada_b, l1_norm1_g, l1_norm2_g, l1_w_qkv, l1_q_norm_g, l1_k_norm_g,
              l1_lam_q1, l1_lam_k1, l1_lam_q2, l1_lam_k2, l1_subln_g, l1_w_out, l1_router,
              l1_exp_w1, l1_exp_w3, l1_exp_w2):
    even = (l0_ada_w, l0_ada_b, l0_norm1_g, l0_norm2_g, l0_w_in, l0_sgu_norm_g, l0_sgu_w, l0_sgu_b,
            l0_shift_w, l0_w0, l0_w_up, l0_a0, l0_a_up, l0_g_up, l0_k_k, l0_k_a, l0_r_k, l0_lnx_w, l0_lnx_b,
            l0_w_out, l0_ffn_w1, l0_ffn_w3, l0_ffn_w2)
    odd = (l1_ada_w, l1_ada_b, l1_norm1_g, l1_norm2_g, l1_w_qkv, l1_q_norm_g, l1_k_norm_g,
           l1_lam_q1, l1_lam_k1, l1_lam_q2, l1_lam_k2, l1_subln_g, l1_w_out, l1_router,
           l1_exp_w1, l1_exp_w3, l1_exp_w2)
    layer_params = (even, odd)
    xc = ctx
    for layer in range(DEPTH):
        if layer % 2 == 0:
            x, xc = even_layer(x, xc, c, c_ctx, *layer_params[layer])
        else:
            x = odd_layer(x, xc, c, c_ctx, lambda_init(layer), *layer_params[layer])
    return x
```

```cpp
#define PHASE_MASK (0x1FFFFFull|(1ull<<22))
#define QKV_F8 1
#define MOE_TAIL_SPLITK 1
#define SCAN_CVPIPE 1
#define F13_F8 1
#define SCAN_HPRIO 1
#define QGRAB 4
#define NT_EPI 1
#include <hip/hip_runtime.h>
#include <cstdio>
#include <cstdint>

#define GAS __attribute__((address_space(1)))
#define LAS __attribute__((address_space(3)))
typedef unsigned short bf16;
typedef unsigned v4u __attribute__((ext_vector_type(4)));
typedef unsigned v2u __attribute__((ext_vector_type(2)));
typedef float f32x4 __attribute__((ext_vector_type(4)));
typedef float f32x2 __attribute__((ext_vector_type(2)));
typedef short bf16x8 __attribute__((ext_vector_type(8)));
typedef float f32x16 __attribute__((ext_vector_type(16)));
typedef short s16x4 __attribute__((ext_vector_type(4)));
#define LDS_WAIT() asm volatile("s_waitcnt lgkmcnt(0)" ::: "memory")
#define VM_WAIT() asm volatile("s_waitcnt vmcnt(0)" ::: "memory")

constexpr int D = 2048, NB = 8, SEQ = 2048, CTX = 256;
constexpr int RL = NB * SEQ, RC = NB * CTX, RT = RL + RC;
constexpr int MIXA = 1024, MIXB = 1024, NIN = 5408, NINP = 5632, ZB = 2048;
constexpr int FF = 5632, DE = 7168, NE = 8;
constexpr int MAXP = 136;
constexpr int MOEROWS = MAXP * 256;

constexpr size_t MiB = 1u << 20;
constexpr size_t WS_CTL = 0, CTL_ZERO_BYTES = 1 * MiB;
constexpr size_t WS_MOD = 1 * MiB;
constexpr size_t WS_SMALLW = 2 * MiB;
constexpr size_t WS_ROUTE = 3 * MiB;
constexpr size_t WS_W = 4 * MiB;
constexpr size_t W_WIN = WS_W, W_WO0 = W_WIN + (size_t)NINP * D * 2, W_W13 = W_WO0 + (size_t)D * D * 2, W_W2 = W_W13 + (size_t)2 * FF * D * 2,
                 W_QKV = W_W2 + (size_t)D * FF * 2, W_WO1 = W_QKV + (size_t)3 * D * D * 2, W_E13 = W_WO1 + (size_t)D * D * 2, W_E2 = W_E13 + (size_t)NE * 2 * DE * D,
                 W_END = W_E13 + 672 * MiB;
static_assert(W_END == 804 * MiB, "weight region = 800 MiB");
constexpr size_t WS_ACTA = 804 * MiB;
constexpr size_t WS_ACTB = WS_ACTA + 72 * MiB;
constexpr size_t WS_ACTC = WS_ACTB + 216 * MiB;
constexpr size_t WS_XC = WS_ACTC + 476 * MiB;
constexpr size_t WS_END = WS_XC + 16 * MiB;
constexpr size_t WS_Y = W_E13 + 336 * MiB;
static_assert(W_E2 + (size_t)NE * D * DE <= WS_Y && WS_Y + (size_t)MOEROWS * D * 4 <= W_END, "Y fits behind the fp8 expert weights");
constexpr float SC_A8 = 8.0f, SC_W13 = 64.0f, SC_H8 = 4.0f, SC_W2 = 128.0f;
static_assert((size_t)MOEROWS * DE * 2 <= 476 * MiB && (size_t)MOEROWS * D * 2 <= 216 * MiB, "MoE buffers fit");
constexpr size_t FEAT_SZ = (size_t)RT * 1024 * 2;
constexpr int CW_TMO = 0;
constexpr int CW_BAR = 4096;
constexpr int CW_Q3 = 64;
constexpr int CW_CQ = 128;
constexpr int CW_TAIL = 16384;
constexpr int CW_DONE = 1024;
constexpr size_t RO_TOPI = 0, RO_TOPG = 128 * 1024, RO_LRANK = 256 * 1024, RO_CNT = 384 * 1024, RO_ROWOF = 512 * 1024;

constexpr int NWAVES = 8;
constexpr int LDS_BYTES = 160 * 1024;
constexpr int RING_OFF = 0, RING_BYTES = 131072, MISC_OFF = 159 * 1024;

__device__ __forceinline__ unsigned f2bf(float f) { unsigned u = __builtin_bit_cast(unsigned, f); return (u + 0x7fffu + ((u >> 16) & 1u)) >> 16; }
typedef __bf16 bf16x2_t __attribute__((ext_vector_type(2)));
__device__ __forceinline__ unsigned pk2(float lo, float hi) { const f32x2 v = {lo, hi}; return __builtin_bit_cast(unsigned, __builtin_convertvector(v, bf16x2_t)); }
__device__ __forceinline__ float bf2f(unsigned short b) { return __builtin_bit_cast(float, (unsigned)b << 16); }
__device__ __forceinline__ float bflo(unsigned w) { return __builtin_bit_cast(float, w << 16); }
__device__ __forceinline__ float bfhi(unsigned w) { return __builtin_bit_cast(float, w & 0xffff0000u); }
__device__ __forceinline__ float wave_sum(float v) {
#pragma unroll
    for (int o = 1; o < 64; o <<= 1) v += __shfl_xor(v, o);
    return v;
}
__device__ __forceinline__ float fast_exp(float x) { return __builtin_amdgcn_exp2f(x * 1.4426950408889634f); }
__device__ __forceinline__ float fast_sigmoid(float x) { return __builtin_amdgcn_rcpf(1.0f + __builtin_amdgcn_exp2f(-x * 1.4426950408889634f)); }
__device__ __forceinline__ float silu_f(float x) { return x * fast_sigmoid(x); }
__device__ __forceinline__ float gelu_tanh_f(float x) { const float z = 0.7978845608028654f * (x + 0.044715f * x * x * x); return x * fast_sigmoid(2.0f * z); }

typedef int v8i32 __attribute__((ext_vector_type(8)));
typedef int v4i32 __attribute__((ext_vector_type(4)));
__device__ __forceinline__ v8i32 cat8(bf16x8 a, bf16x8 b) { const v4i32 x = __builtin_bit_cast(v4i32, a), y = __builtin_bit_cast(v4i32, b); return __builtin_shufflevector(x, y, 0, 1, 2, 3, 4, 5, 6, 7); }
__device__ __forceinline__ float clamp8(float x) { return __builtin_amdgcn_fmed3f(x, -448.0f, 448.0f); }
__device__ __forceinline__ unsigned pk4_fp8(float a, float b, float c, float d) {
    int w = 0; w = __builtin_amdgcn_cvt_pk_fp8_f32(clamp8(a), clamp8(b), w, false); w = __builtin_amdgcn_cvt_pk_fp8_f32(clamp8(c), clamp8(d), w, true); return (unsigned)w; }
__device__ __forceinline__ void mfma_f8_tied(f32x4& acc, v8i32 a, v8i32 b, int sc) {
    asm volatile("v_mfma_scale_f32_16x16x128_f8f6f4 %0, %1, %2, %0, %3, %3 op_sel_hi:[0,0,0]" : "+v"(acc) : "v"(a), "v"(b), "v"(sc));
}
namespace pg8 {
#define PG8_LAS __attribute__((address_space(3)))
typedef unsigned short bf16_t;
typedef short bf16x8 __attribute__((ext_vector_type(8)));
typedef float f32x4 __attribute__((ext_vector_type(4)));
typedef unsigned u32x4 __attribute__((ext_vector_type(4)));
constexpr int BM = 256, BK = 64, HALF = 128, HTB = HALF * BK * 2, STAGE_BYTES = 8 * HTB, NXCD = 8, WGM = 8;
__host__ __device__ __forceinline__ int lds_byte(int r, int c) { const int st = (r >> 4) * 2 + (c >> 5), rr = r & 15, cc = c & 31, ob = rr * 64 + cc * 2; return st * 1024 + (ob ^ (((ob >> 9) & 1) << 5)); }
__host__ __device__ __forceinline__ void stage_rc(int b, int& R, int& C) { const int st = b / 1024, sb = b % 1024, swz = sb ^ (((sb >> 9) & 1) << 5); R = (st >> 1) * 16 + swz / 64; C = (st & 1) * 32 + (swz % 64) / 2; }
__host__ __device__ __forceinline__ int perm32(int rho) { const int n = rho >> 4, i = rho & 15; return 8 * (i >> 2) + 4 * n + (i & 3); }
#ifdef NT_EPI
#define NT_ST(p, v) __builtin_nontemporal_store((v), (p))
#else
#define NT_ST(p, v) (*(p) = (v))
#endif
struct Unit { int pm, pn, pb, ko, tj; };
struct Gemm { const bf16_t* A; const bf16_t* Bt; int M, N, K; int nt = 0; };
struct StaticOrder {
    int nM, nN, nwg, G, c;
    __host__ __device__ void init(int M, int N, int G_, int c_) { nM = M / BM; nN = N / BM; nwg = nM * nN; G = G_; c = c_; }
    __host__ __device__ bool next(int i, Unit& u) const {
        const long L = (long)i * G + c; if (L >= nwg) return false;
        int wgid = (int)L; { const int q = nwg / NXCD, r = nwg % NXCD, xcd = wgid % NXCD, off = wgid / NXCD; wgid = (xcd < r ? xcd * (q + 1) : r * (q + 1) + (xcd - r) * q) + off; }
        const int nig = WGM * nN, gid = wgid / nig, fm = gid * WGM, gsz = (nM - fm) < WGM ? (nM - fm) : WGM;
        u.pm = fm + ((wgid % nig) % gsz); u.pn = (wgid % nig) / gsz; u.pb = u.pn; u.ko = 0; u.tj = 0; return true;
    }
    __device__ __forceinline__ void a_ready(const Unit&) const {}
    __device__ __forceinline__ void done(const Unit&) const {}
};
struct GroupedOrder {
    int nM, nN, nwg, G, c, lim; const LAS int* ptab;
    __device__ void init(int nPanels, int N, int G_, int c_, const LAS int* pt) { nM = nPanels; nN = N / BM; nwg = nM * nN; G = G_; c = c_; ptab = pt; lim = nwg; }
    __device__ __forceinline__ void map(int L, Unit& u) const {
        int wgid = L; { const int q = nwg / NXCD, r = nwg % NXCD, xcd = wgid % NXCD, off = wgid / NXCD; wgid = (xcd < r ? xcd * (q + 1) : r * (q + 1) + (xcd - r) * q) + off; }
        const int nig = WGM * nN, gid = wgid / nig, fm = gid * WGM, gsz = (nM - fm) < WGM ? (nM - fm) : WGM;
        u.pm = fm + ((wgid % nig) % gsz); u.pn = (wgid % nig) / gsz; u.pb = __builtin_amdgcn_readfirstlane(ptab[u.pm]) * nN + u.pn; u.ko = 0; u.tj = 0;
    }
    __device__ __forceinline__ bool next(int i, Unit& u) const { const long L = (long)i * G + c; if (L >= lim) return false; map((int)L, u); return true; }
    __device__ __forceinline__ void a_ready(const Unit&) const {}
    __device__ __forceinline__ void done(const Unit&) const {}
};
struct TailOrder {
    GroupedOrder base; int L0, S, kslice;
    __device__ __forceinline__ bool next(int i, Unit& u) const { if (i > 0 || base.c >= (base.nwg - L0) * S) return false; base.map(L0 + base.c / S, u); u.ko = (base.c % S) * kslice; u.tj = base.c; return true; }
    __device__ __forceinline__ void a_ready(const Unit&) const {}
    __device__ __forceinline__ void done(const Unit&) const {}
};
__device__ __forceinline__ unsigned cvt_pk_bf16(float lo, float hi) { unsigned r; asm volatile("v_cvt_pk_bf16_f32 %0, %1, %2" : "=v"(r) : "v"(lo), "v"(hi)); return r; }

struct EpiBf16G {
    static constexpr bool PERM = true, AFTER_DRAIN = false;
    bf16_t* O; int ldc; int gelu_tiles; float scale = 1.0f;
    __device__ __forceinline__ void operator()(const f32x4 (&acc)[2][2][4][2], const Unit& u, int wr, int wc, int fr, int fq) const {
        const int row0 = u.pm * BM + wr * 64 + fr, col0 = u.pn * BM + wc * 32 + 8 * fq; const bool act = u.pn < gelu_tiles;
#pragma unroll
        for (int ai = 0; ai < 2; ++ai)
#pragma unroll
            for (int m = 0; m < 4; ++m) { bf16_t* rowp = O + (size_t)(row0 + ai * HALF + m * 16) * ldc + col0;
#pragma unroll
                for (int bj = 0; bj < 2; ++bj) { f32x4 v0 = acc[ai][bj][m][0] * scale, v1 = acc[ai][bj][m][1] * scale;
                    if (act) {
#pragma unroll
                        for (int j = 0; j < 4; ++j) { v0[j] = gelu_tanh_f(v0[j]); v1[j] = gelu_tanh_f(v1[j]); } }
                    u32x4 w; w.x = cvt_pk_bf16(v0[0], v0[1]); w.y = cvt_pk_bf16(v0[2], v0[3]); w.z = cvt_pk_bf16(v1[0], v1[1]); w.w = cvt_pk_bf16(v1[2], v1[3]);
                    NT_ST((u32x4*)(rowp + bj * HALF), w); } }
    }
};
struct EpiSwiGLU {
    static constexpr bool PERM = true, AFTER_DRAIN = false;
    bf16_t* O; int ldc; float is = 1.0f;
    __device__ __forceinline__ void operator()(const f32x4 (&acc)[2][2][4][2], const Unit& u, int wr, int wc, int fr, int fq) const {
        const int row0 = u.pm * BM + wr * 64 + fr, col0 = u.pn * HALF + wc * 32 + 8 * fq;
#pragma unroll
        for (int ai = 0; ai < 2; ++ai)
#pragma unroll
            for (int m = 0; m < 4; ++m) { bf16_t* rowp = O + (size_t)(row0 + ai * HALF + m * 16) * ldc + col0;
                f32x4 v0, v1;
#pragma unroll
                for (int j = 0; j < 4; ++j) { v0[j] = silu_f(acc[ai][0][m][0][j] * is) * (acc[ai][1][m][0][j] * is); v1[j] = silu_f(acc[ai][0][m][1][j] * is) * (acc[ai][1][m][1][j] * is); }
                u32x4 w; w.x = cvt_pk_bf16(v0[0], v0[1]); w.y = cvt_pk_bf16(v0[2], v0[3]); w.z = cvt_pk_bf16(v1[0], v1[1]); w.w = cvt_pk_bf16(v1[2], v1[3]);
                *(u32x4*)rowp = w; }
    }
};
struct EpiResGate {
    static constexpr bool PERM = false, AFTER_DRAIN = false;
    const float* res_l; const float* res_c; float* out_l; float* out_c; const float* gate; float scale;
    __device__ __forceinline__ void operator()(const f32x4 (&acc)[2][2][4][2], const Unit& u, int wr, int wc, int fr, int fq) const {
        const bool lat = u.pm < 64; const int mrow = lat ? (u.pm >> 3) : 8; const size_t pbase = (size_t)(lat ? u.pm : u.pm - 64) * BM * 2048;
        const float* rb = (lat ? res_l : res_c) + pbase; float* ob = (lat ? out_l : out_c) + pbase; const float* gp = gate + (size_t)mrow * (6 * 2048);
        const int row0 = wr * 64 + fr, col0 = u.pn * BM + wc * 32 + 4 * fq;
        f32x4 gv[2][2];
#pragma unroll
        for (int bj = 0; bj < 2; ++bj)
#pragma unroll
            for (int n = 0; n < 2; ++n) gv[bj][n] = *(const f32x4*)(gp + col0 + bj * HALF + n * 16) * scale;
        f32x4 rc[2][2], rn[2][2];
#pragma unroll
        for (int bj = 0; bj < 2; ++bj)
#pragma unroll
            for (int n = 0; n < 2; ++n) rc[bj][n] = *(const f32x4*)(rb + (size_t)row0 * 2048 + col0 + bj * HALF + n * 16);
#pragma unroll
        for (int idx = 0; idx < 8; ++idx) { const int ai = idx >> 2, m = idx & 3; const size_t off = (size_t)(row0 + ai * HALF + m * 16) * 2048 + col0;
            if (idx + 1 < 8) { const int ai1 = (idx + 1) >> 2, m1 = (idx + 1) & 3; const size_t off1 = (size_t)(row0 + ai1 * HALF + m1 * 16) * 2048 + col0;
#pragma unroll
                for (int bj = 0; bj < 2; ++bj)
#pragma unroll
                    for (int n = 0; n < 2; ++n) rn[bj][n] = *(const f32x4*)(rb + off1 + bj * HALF + n * 16); }
#pragma unroll
            for (int bj = 0; bj < 2; ++bj)
#pragma unroll
                for (int n = 0; n < 2; ++n) { *(f32x4*)(ob + off + bj * HALF + n * 16) = rc[bj][n] + gv[bj][n] * acc[ai][bj][m][n]; rc[bj][n] = rn[bj][n]; }
            asm volatile("" ::: "memory"); }
    }
};
struct EpiF32 {
    static constexpr bool PERM = false, AFTER_DRAIN = false;
    float* C; int ldc;
    __device__ __forceinline__ void operator()(const f32x4 (&acc)[2][2][4][2], const Unit& u, int wr, int wc, int fr, int fq) const {
        const int row0 = u.pm * BM + wr * 64 + fr, col0 = u.pn * BM + wc * 32 + 4 * fq;
#pragma unroll
        for (int ai = 0; ai < 2; ++ai)
#pragma unroll
            for (int m = 0; m < 4; ++m) { float* rowp = C + (size_t)(row0 + ai * HALF + m * 16) * ldc + col0;
#pragma unroll
                for (int bj = 0; bj < 2; ++bj)
#pragma unroll
                    for (int n = 0; n < 2; ++n) *(f32x4*)(rowp + bj * HALF + n * 16) = acc[ai][bj][m][n]; }
    }
};
struct EpiSwiGLU8 {
    static constexpr bool PERM = true, AFTER_DRAIN = false;
    unsigned char* O; int ldc; float is;
    __device__ __forceinline__ void operator()(const f32x4 (&acc)[2][2][4][2], const Unit& u, int wr, int wc, int fr, int fq) const {
        const int row0 = u.pm * BM + wr * 64 + fr, col0 = u.pn * HALF + wc * 32 + 8 * fq; const float ke = -1.4426950408889634f * is, kq = is * is * SC_H8;
#pragma unroll
        for (int ai = 0; ai < 2; ++ai)
#pragma unroll
            for (int m = 0; m < 4; ++m) { unsigned char* rowp = O + (size_t)(row0 + ai * HALF + m * 16) * ldc + col0;
                f32x4 v0, v1;
#pragma unroll
                for (int j = 0; j < 4; ++j) {
                    const float g0 = acc[ai][0][m][0][j], g1 = acc[ai][0][m][1][j];
                    v0[j] = (g0 * acc[ai][1][m][0][j]) * (kq * __builtin_amdgcn_rcpf(1.0f + __builtin_amdgcn_exp2f(g0 * ke)));
                    v1[j] = (g1 * acc[ai][1][m][1][j]) * (kq * __builtin_amdgcn_rcpf(1.0f + __builtin_amdgcn_exp2f(g1 * ke))); }
                v2u w; w.x = pk4_fp8(v0[0], v0[1], v0[2], v0[3]); w.y = pk4_fp8(v1[0], v1[1], v1[2], v1[3]);
                NT_ST((v2u*)rowp, w); }
    }
};
struct EpiF32S {
    static constexpr bool PERM = false, AFTER_DRAIN = false;
    float* C; int ldc; float scale;
    __device__ __forceinline__ void operator()(const f32x4 (&acc)[2][2][4][2], const Unit& u, int wr, int wc, int fr, int fq) const {
        const int row0 = u.pm * BM + wr * 64 + fr, col0 = u.pn * BM + wc * 32 + 4 * fq;
#pragma unroll
        for (int ai = 0; ai < 2; ++ai)
#pragma unroll
            for (int m = 0; m < 4; ++m) { float* rowp = C + (size_t)(row0 + ai * HALF + m * 16) * ldc + col0;
#pragma unroll
                for (int bj = 0; bj < 2; ++bj)
#pragma unroll
                    for (int n = 0; n < 2; ++n) *(f32x4*)(rowp + bj * HALF + n * 16) = acc[ai][bj][m][n] * scale; }
    }
};
struct EpiBf16S {
    static constexpr bool PERM = true, AFTER_DRAIN = false;
    bf16_t* O; int ldc; float scale;
    __device__ __forceinline__ void operator()(const f32x4 (&acc)[2][2][4][2], const Unit& u, int wr, int wc, int fr, int fq) const {
        const int row0 = u.pm * BM + wr * 64 + fr, col0 = u.pn * BM + wc * 32 + 8 * fq;
#pragma unroll
        for (int ai = 0; ai < 2; ++ai)
#pragma unroll
            for (int m = 0; m < 4; ++m) { bf16_t* rowp = O + (size_t)(row0 + ai * HALF + m * 16) * ldc + col0;
#pragma unroll
                for (int bj = 0; bj < 2; ++bj) { const f32x4 v0 = acc[ai][bj][m][0] * scale, v1 = acc[ai][bj][m][1] * scale;
                    u32x4 w; w.x = cvt_pk_bf16(v0[0], v0[1]); w.y = cvt_pk_bf16(v0[2], v0[3]); w.z = cvt_pk_bf16(v1[0], v1[1]); w.w = cvt_pk_bf16(v1[2], v1[3]);
                    NT_ST((u32x4*)(rowp + bj * HALF), w); } }
    }
};
struct EpiSplitK {
    static constexpr bool PERM = true, AFTER_DRAIN = false;
    float* P;
    __device__ __forceinline__ void operator()(const f32x4 (&acc)[2][2][4][2], const Unit& u, int wr, int wc, int fr, int fq) const {
        float* Pt = P + (size_t)u.tj * 65536; const int lr0 = wr * 64 + fr, lc0 = wc * 32 + 8 * fq;
#pragma unroll
        for (int ai = 0; ai < 2; ++ai)
#pragma unroll
            for (int m = 0; m < 4; ++m)
#pragma unroll
                for (int bj = 0; bj < 2; ++bj) { float* p = Pt + (size_t)(lr0 + ai * HALF + m * 16) * 256 + lc0 + bj * HALF; *(f32x4*)p = acc[ai][bj][m][0]; *(f32x4*)(p + 4) = acc[ai][bj][m][1]; }
    }
};
template <class Epi, class Sched, bool ALIGN_EPI = false, bool SP2 = false, bool F8 = false>
__device__ __forceinline__ void gemm_phase(PG8_LAS unsigned char* lds, const Gemm g, const Sched& S, const Epi& E, const int wid) {
    const int lane = (int)__builtin_amdgcn_mbcnt_hi(~0u, __builtin_amdgcn_mbcnt_lo(~0u, 0u)), tid = wid * 64 + lane, wr = wid >> 2, wc = wid & 3, fr = lane & 15, fq = lane >> 4;
    const int K = g.K, nt = g.nt ? g.nt : K / BK;
    unsigned voffA[2], voffB[2];
#pragma unroll
    for (int i = 0; i < 2; ++i) { int R, C; stage_rc(tid * 16 + i * 8192, R, C); const int Rb = Epi::PERM ? ((R & ~31) + perm32(R & 31)) : R;
        voffA[i] = (unsigned)(R * K + C) * 2u; voffB[i] = (unsigned)(Rb * K + C) * 2u; }
    const size_t kstep = (size_t)(BK * 2);
    const size_t hstep = (size_t)HALF * K * 2;
    const size_t tstep = 2 * hstep;
    const unsigned ldsw = (unsigned)wid * 1024u;
    const int aoff = lds_byte(wr * 64 + fr, fq * 8), boff = lds_byte(wc * 32 + fr, fq * 8);
#define PG8_SA(b, h) (((b) * 2 + (h)) * HTB)
#define PG8_SB(b, h) ((4 + (b) * 2 + (h)) * HTB)
    const __amdgpu_buffer_rsrc_t rsrcA = __builtin_amdgcn_make_buffer_rsrc((void*)g.A, 0, -1, 0x00020000), rsrcB = __builtin_amdgcn_make_buffer_rsrc((void*)g.Bt, 0, -1, 0x00020000);
#define PG8_STAGE(bufoff, gbase, voff) do { if constexpr (F8) { const bool _isA = ((voff) == voffA); const int _so = (int)(unsigned)((const char*)(gbase) - (const char*)(_isA ? (const void*)g.A : (const void*)g.Bt)); \
        _Pragma("unroll") for (int _i = 0; _i < 2; ++_i) __builtin_amdgcn_raw_ptr_buffer_load_lds(_isA ? rsrcA : rsrcB, (PG8_LAS unsigned*)(lds + (bufoff) + ldsw + _i * 8192), 16, (int)(voff)[_i], _so, 0, 0); } \
      else { _Pragma("unroll") for (int _i = 0; _i < 2; ++_i) \
        __builtin_amdgcn_global_load_lds((const unsigned*)((const char*)(gbase) + (voff)[_i]), (PG8_LAS unsigned*)(lds + (bufoff) + ldsw + _i * 8192), 16, 0, 0); } } while (0)
#define PG8_LDA(dst, b, h) do { _Pragma("unroll") for (int m = 0; m < 4; ++m) _Pragma("unroll") for (int k = 0; k < 2; ++k) dst[m][k] = *(const PG8_LAS bf16x8*)(lds + PG8_SA(b, h) + aoff + m * 2048 + k * 1024); } while (0)
#define PG8_LDB(dst, b, h) do { _Pragma("unroll") for (int n = 0; n < 2; ++n) _Pragma("unroll") for (int k = 0; k < 2; ++k) dst[n][k] = *(const PG8_LAS bf16x8*)(lds + PG8_SB(b, h) + boff + n * 2048 + k * 1024); } while (0)
#define PG8_MMAZ(ai, bj, At, Bt, Z) do { __builtin_amdgcn_s_setprio(1); \
        if constexpr (F8) { _Pragma("unroll") for (int m = 0; m < 4; ++m) _Pragma("unroll") for (int n = 0; n < 2; ++n) \
            mfma_f8_tied(acc[ai][bj][m][n], cat8(Bt[n][0], Bt[n][1]), cat8(At[m][0], At[m][1]), f8scale); } \
        else { _Pragma("unroll") for (int m = 0; m < 4; ++m) _Pragma("unroll") for (int n = 0; n < 2; ++n) _Pragma("unroll") for (int k = 0; k < 2; ++k) \
            acc[ai][bj][m][n] = __builtin_amdgcn_mfma_f32_16x16x32_bf16(Bt[n][k], At[m][k], ((Z) && k == 0) ? (f32x4){0.f, 0.f, 0.f, 0.f} : acc[ai][bj][m][n], 0, 0, 0); } \
        __builtin_amdgcn_s_setprio(0); } while (0)
#define PG8_MMA(ai, bj, At, Bt) PG8_MMAZ(ai, bj, At, Bt, false)
#define PG8_WAIT_V(n) asm volatile("s_waitcnt vmcnt(" #n ")" ::: "memory")
#define PG8_WAIT_L(n) asm volatile("s_waitcnt lgkmcnt(" #n ")" ::: "memory")
#define PG8_BAR __builtin_amdgcn_s_barrier()
#define PG8_SCHED __builtin_amdgcn_sched_barrier(0)
#define PG8_KBODY(ZF) \
            const bool last = (t == nt - 2); \
            const char* a1 = cA + (size_t)(t + 1) * kstep; \
            const char* a2 = last ? nA : cA + (size_t)(t + 2) * kstep; const char* b2 = last ? nB : cB + (size_t)(t + 2) * kstep; \
            const char* a3 = a2 + kstep; const char* b3 = b2 + kstep; \
            if (last && has_next) S.a_ready(nxt); \
            if constexpr (SP2) { \
            PG8_LDB(B0, 0, 0); PG8_LDB(B1, 0, 1); PG8_SCHED; PG8_LDA(At, 0, 0); PG8_STAGE(PG8_SA(1, 1), a1 + hstep, voffA); \
            PG8_WAIT_V(8); PG8_WAIT_L(0); PG8_BAR; PG8_MMAZ(0, 0, At, B0, ZF); PG8_MMAZ(0, 1, At, B1, ZF); PG8_BAR; PG8_SCHED; \
            PG8_LDA(At, 0, 1); PG8_STAGE(PG8_SB(0, 0), b2, voffB); PG8_STAGE(PG8_SB(0, 1), b2 + hstep, voffB); PG8_STAGE(PG8_SA(0, 0), a2, voffA); \
            PG8_WAIT_V(8); PG8_WAIT_L(0); PG8_BAR; PG8_MMAZ(1, 0, At, B0, ZF); PG8_MMAZ(1, 1, At, B1, ZF); PG8_BAR; PG8_SCHED; \
            PG8_LDB(B0, 1, 0); PG8_LDB(B1, 1, 1); PG8_SCHED; PG8_LDA(At, 1, 0); PG8_STAGE(PG8_SA(0, 1), a2 + hstep, voffA); \
            PG8_WAIT_V(8); PG8_WAIT_L(0); PG8_BAR; PG8_MMA(0, 0, At, B0); PG8_MMA(0, 1, At, B1); PG8_BAR; PG8_SCHED; \
            PG8_LDA(At, 1, 1); PG8_STAGE(PG8_SB(1, 0), b3, voffB); PG8_STAGE(PG8_SB(1, 1), b3 + hstep, voffB); PG8_STAGE(PG8_SA(1, 0), a3, voffA); \
            PG8_WAIT_V(8); PG8_WAIT_L(0); PG8_BAR; PG8_MMA(1, 0, At, B0); PG8_MMA(1, 1, At, B1); PG8_BAR; PG8_SCHED; \
            } else { \
            PG8_LDB(B0, 0, 0); PG8_SCHED; PG8_LDA(At, 0, 0); PG8_STAGE(PG8_SA(1, 1), a1 + hstep, voffA); \
            PG8_WAIT_L(8); PG8_BAR; PG8_WAIT_L(0); PG8_MMAZ(0, 0, At, B0, ZF); PG8_BAR; PG8_SCHED; \
            PG8_LDB(B1, 0, 1); PG8_STAGE(PG8_SB(0, 0), b2, voffB); \
            PG8_BAR; PG8_WAIT_L(0); PG8_MMAZ(0, 1, At, B1, ZF); PG8_BAR; \
            PG8_LDA(At, 0, 1); PG8_STAGE(PG8_SA(0, 0), a2, voffA); \
            PG8_BAR; PG8_WAIT_L(0); PG8_MMAZ(1, 0, At, B0, ZF); PG8_BAR; PG8_SCHED; \
            PG8_STAGE(PG8_SB(0, 1), b2 + hstep, voffB); \
            PG8_WAIT_V(6); PG8_BAR; PG8_MMAZ(1, 1, At, B1, ZF); PG8_BAR; \
            PG8_LDB(B0, 1, 0); PG8_SCHED; PG8_LDA(At, 1, 0); PG8_STAGE(PG8_SA(0, 1), a2 + hstep, voffA); \
            PG8_WAIT_L(8); PG8_BAR; PG8_WAIT_L(0); PG8_MMA(0, 0, At, B0); PG8_BAR; PG8_SCHED; \
            PG8_LDB(B1, 1, 1); PG8_STAGE(PG8_SB(1, 0), b3, voffB); \
            PG8_BAR; PG8_WAIT_L(0); PG8_MMA(0, 1, At, B1); PG8_BAR; \
            PG8_LDA(At, 1, 1); PG8_STAGE(PG8_SA(1, 0), a3, voffA); \
            PG8_BAR; PG8_WAIT_L(0); PG8_MMA(1, 0, At, B0); PG8_BAR; PG8_SCHED; \
            PG8_STAGE(PG8_SB(1, 1), b3 + hstep, voffB); \
            PG8_WAIT_V(6); PG8_BAR; PG8_MMA(1, 1, At, B1); PG8_BAR; \
            }
    Unit cur, nxt; int ui = 0;
    if (!S.next(0, cur)) return;
    f32x4 acc[2][2][4][2];
    int f8scale = 0x7F7F7F7F; if constexpr (F8) asm volatile("" : "+v"(f8scale));
    {
#pragma unroll
    for (int a = 0; a < 2; ++a)
#pragma unroll
        for (int b = 0; b < 2; ++b)
#pragma unroll
            for (int m = 0; m < 4; ++m)
#pragma unroll
                for (int n = 0; n < 2; ++n) acc[a][b][m][n] = (f32x4){0.f, 0.f, 0.f, 0.f};
    }
    bf16x8 At[4][2], B0[2][2], B1[2][2];
    const char* cA = (const char*)g.A + (size_t)cur.pm * tstep + cur.ko; const char* cB = (const char*)g.Bt + (size_t)cur.pb * tstep + cur.ko;
    S.a_ready(cur);
    if constexpr (SP2) {
        PG8_STAGE(PG8_SB(0, 0), cB, voffB); PG8_STAGE(PG8_SB(0, 1), cB + hstep, voffB); PG8_STAGE(PG8_SA(0, 0), cA, voffA); PG8_STAGE(PG8_SA(0, 1), cA + hstep, voffA);
        if (wr == 1) PG8_BAR;
        PG8_WAIT_V(2); PG8_BAR;
        PG8_STAGE(PG8_SB(1, 0), cB + kstep, voffB); PG8_STAGE(PG8_SA(1, 0), cA + kstep, voffA); PG8_STAGE(PG8_SB(1, 1), cB + hstep + kstep, voffB);
        PG8_WAIT_V(6); PG8_BAR;
    } else {
        PG8_STAGE(PG8_SB(0, 0), cB, voffB); PG8_STAGE(PG8_SA(0, 0), cA, voffA); PG8_STAGE(PG8_SB(0, 1), cB + hstep, voffB); PG8_STAGE(PG8_SA(0, 1), cA + hstep, voffA);
        if (wr == 1) PG8_BAR;
        PG8_WAIT_V(4); PG8_BAR;
        PG8_STAGE(PG8_SB(1, 0), cB + kstep, voffB); PG8_STAGE(PG8_SA(1, 0), cA + kstep, voffA); PG8_STAGE(PG8_SB(1, 1), cB + hstep + kstep, voffB);
        PG8_WAIT_V(6); PG8_BAR;
    }
    for (;;) {
        const bool has_next = S.next(ui + 1, nxt);
        const char* nA = has_next ? (const char*)g.A + (size_t)nxt.pm * tstep + nxt.ko : cA; const char* nB = has_next ? (const char*)g.Bt + (size_t)nxt.pb * tstep + nxt.ko : cB;
        for (int t = 0; t < nt; t += 2) { PG8_KBODY(false) }
        if constexpr (F8) asm volatile("s_nop 15\n\ts_nop 15" ::: "memory");
        if constexpr (ALIGN_EPI) { if (wr == 0) PG8_BAR; }
        if constexpr (!Epi::AFTER_DRAIN) { E(acc, cur, wr, wc, fr, fq); S.done(cur); }
        if (!has_next) break;
        {
#pragma unroll
    for (int a = 0; a < 2; ++a)
#pragma unroll
        for (int b = 0; b < 2; ++b)
#pragma unroll
            for (int m = 0; m < 4; ++m)
#pragma unroll
                for (int n = 0; n < 2; ++n) acc[a][b][m][n] = (f32x4){0.f, 0.f, 0.f, 0.f};
        }
        cur = nxt; cA = nA; cB = nB; ++ui;
        if constexpr (ALIGN_EPI) { if (wr == 1) PG8_BAR; }
    }
    PG8_WAIT_V(0);
    if constexpr (!ALIGN_EPI) { if (wr == 0) PG8_BAR; }
    PG8_BAR;
    if constexpr (Epi::AFTER_DRAIN) { E.fused(acc, cur, wr, wc, fr, fq, lds, wid, lane); S.done(cur); }
#undef PG8_SA
#undef PG8_SB
#undef PG8_STAGE
#undef PG8_LDA
#undef PG8_LDB
#undef PG8_MMA
#undef PG8_MMAZ
#undef PG8_KBODY
#undef PG8_WAIT_V
#undef PG8_WAIT_L
#undef PG8_BAR
#undef PG8_SCHED
}
}
#define XB_TMO      128
#define XB_XCNT(j)  (256  + 64 * (j))
#define XB_XSUB(j)  (1280 + 64 * (j))
#define XB_XGEN(j)  (2304 + 64 * (j))
#define XB_TOP      3328
#define XB_TOPGEN   3392
#define XCD_BAR_WORDS 3456
#define XB_SPIN_CAP (1u << 18)

__device__ __forceinline__ unsigned xb_ld(unsigned* p)              { return __hip_atomic_load(p, __ATOMIC_RELAXED, __HIP_MEMORY_SCOPE_AGENT); }
__device__ __forceinline__ unsigned xb_add(unsigned* p, unsigned v) { return __hip_atomic_fetch_add(p, v, __ATOMIC_RELAXED, __HIP_MEMORY_SCOPE_AGENT); }
__device__ __forceinline__ unsigned xb_xcc_id() { return (unsigned)__builtin_amdgcn_s_getreg((3 << 11) | 20) & 0xFu; }
#define XB_SPIN(cond, bar) do { unsigned _sp = 0; while (cond) { __builtin_amdgcn_s_sleep(1); \
    if ((++_sp & 255u) == 0u) { if (xb_ld(&(bar)[XB_TMO])) break; if (_sp > XB_SPIN_CAP) { atomicAdd(&(bar)[XB_TMO], 1u); break; } } } } while (0)

struct XcdBarrier {
    unsigned* bar; unsigned x; unsigned wave;
    volatile LAS unsigned* st;
};

__device__ __forceinline__ XcdBarrier xcd_barrier_post(unsigned* bar, volatile LAS unsigned* st) {
    XcdBarrier b; b.bar = bar; b.x = xb_xcc_id(); b.st = st;
    if (threadIdx.x == 0) (void)xb_add(&bar[XB_XCNT(b.x)], 1u);
    b.wave = (unsigned)__builtin_amdgcn_readfirstlane(threadIdx.x >> 6);
    return b;
}
__device__ __forceinline__ void xcd_barrier_complete(unsigned* bar, unsigned x, unsigned& nloc, unsigned& nx) {
    const unsigned G = gridDim.x * gridDim.y * gridDim.z;
    unsigned sum, cnt, mine, sp = 0u;
    for (;;) {
        sum = 0u; cnt = 0u; mine = 0u;
#pragma unroll
        for (unsigned j = 0; j < 16; ++j) { const unsigned c = xb_ld(&bar[XB_XCNT(j)]); sum += c; cnt += (c > 0u) ? 1u : 0u; mine = (j == x) ? c : mine; }
        if (sum == G) break;
        __builtin_amdgcn_s_sleep(1);
        if ((++sp & 255u) == 0u) { if (xb_ld(&bar[XB_TMO])) break; if (sp > XB_SPIN_CAP) { atomicAdd(&bar[XB_TMO], 1u); break; } }
    }
    nloc = mine > 0u ? mine : 1u; nx = cnt > 0u ? cnt : 1u;
}

__device__ __forceinline__ void xcd_barrier(const XcdBarrier& b) {
    asm volatile("s_waitcnt vmcnt(0)" ::: "memory");
    __syncthreads();
    unsigned bl_; asm volatile("v_mbcnt_lo_u32_b32 %0, -1, 0\n\tv_mbcnt_hi_u32_b32 %0, -1, %0" : "=v"(bl_));
    if (b.wave == 0u && bl_ == 0u) {
        unsigned* bar = b.bar;
        __builtin_amdgcn_s_waitcnt(0);
        unsigned nloc = b.st[0], nx = b.st[1];
        if (nloc == 0u) { xcd_barrier_complete(bar, b.x, nloc, nx); b.st[0] = nloc; b.st[1] = nx; }
        const unsigned old = xb_add(&bar[XB_XSUB(b.x)], 1u);
        const unsigned gen = old / nloc;
        if (old + 1u == (gen + 1u) * nloc) {
            __builtin_amdgcn_fence(__ATOMIC_RELEASE, "agent");
            asm volatile("s_waitcnt vmcnt(0)" ::: "memory");
            const unsigned og = xb_add(&bar[XB_TOP], 1u);
            const unsigned tg = og / nx;
            if (og + 1u == (tg + 1u) * nx) xb_add(&bar[XB_TOPGEN], 1u);
            else XB_SPIN(xb_ld(&bar[XB_TOPGEN]) == tg, bar);
            __builtin_amdgcn_fence(__ATOMIC_ACQUIRE, "agent");
            xb_add(&bar[XB_XGEN(b.x)], 1u);
            asm volatile("s_waitcnt vmcnt(0)" ::: "memory");
        } else {
            XB_SPIN(xb_ld(&bar[XB_XGEN(b.x)]) == gen, bar);
            __builtin_amdgcn_fence(__ATOMIC_ACQUIRE, "agent");
            asm volatile("s_waitcnt vmcnt(0)" ::: "memory");
        }
    }
    __syncthreads();
}

struct Frame {
    LAS unsigned char* lds;
    volatile LAS unsigned* MISC;
    unsigned* ctl;
    int tid, lane, wave, G;
    float* out; unsigned char* ws;
};
#define WSP(T, off) ((T*)(F.ws + (off)))
#if defined(__HIP_DEVICE_COMPILE__)
typedef __attribute__((address_space(4))) const char* kargp_t;
__device__ __forceinline__ kargp_t karg_base() { kargp_t p = (kargp_t)__builtin_amdgcn_kernarg_segment_ptr(); asm volatile("" : "+s"(p)); return p; }
#define KIN(i) (((__attribute__((address_space(4))) const float* const*)karg_base())[i])
#else
#define KIN(i) ((const float*)nullptr)
#endif

struct TrItem { const float* src; int ldsrc; int valid; unsigned char* dst; int dstKb; int kind; float scale; };
__device__ __forceinline__ int gate_up_row(int n0) { return (n0 >> 7) * 256 + (n0 & 127); }
__device__ __forceinline__ void tr_load(const TrItem& t, f32x4 (&v)[8], int lane) {
#pragma unroll
    for (int i = 0; i < 8; ++i) { const int kk = 8 * i + (lane >> 3); v[i] = t.valid ? *(const f32x4*)(t.src + (size_t)kk * t.ldsrc + 4 * (lane & 7)) : (f32x4){0.f, 0.f, 0.f, 0.f}; }
}
__device__ __forceinline__ void tr_store(const TrItem& t, const f32x4 (&v)[8], LAS float* scr, int lane) {
    if (t.kind == 0) {
#pragma unroll
        for (int i = 0; i < 8; ++i) { const int kk = 8 * i + (lane >> 3); *(LAS f32x4*)(scr + kk * 32 + ((4 * (lane & 7)) ^ (((kk >> 3) << 2) & 31))) = v[i]; }
        LDS_WAIT(); asm volatile("" ::: "memory");
        const int c = lane & 7;
#pragma unroll
        for (int j = 0; j < 4; ++j) { const int n = (lane >> 3) + 8 * j; const LAS float* s = scr + (8 * c) * 32 + (n ^ ((c << 2) & 31));
            v4u o; o.x = pk2(s[0 * 32], s[1 * 32]); o.y = pk2(s[2 * 32], s[3 * 32]); o.z = pk2(s[4 * 32], s[5 * 32]); o.w = pk2(s[6 * 32], s[7 * 32]);
            *(GAS v4u*)(t.dst + (size_t)n * t.dstKb + 16 * c) = o; }
    } else {
#pragma unroll
        for (int i = 0; i < 8; ++i) { const int kk = 8 * i + (lane >> 3); *(LAS f32x4*)(scr + kk * 32 + ((4 * (lane & 7)) ^ (((kk >> 4) & 3) << 3))) = v[i] * t.scale; }
        LDS_WAIT(); asm volatile("" ::: "memory");
        const int c = lane & 3;
#pragma unroll
        for (int j = 0; j < 2; ++j) { const int n = (lane >> 2) + 16 * j; const LAS float* s = scr + (16 * c) * 32 + (n ^ (c << 3));
            v4u o; o.x = pk4_fp8(s[0 * 32], s[1 * 32], s[2 * 32], s[3 * 32]); o.y = pk4_fp8(s[4 * 32], s[5 * 32], s[6 * 32], s[7 * 32]);
            o.z = pk4_fp8(s[8 * 32], s[9 * 32], s[10 * 32], s[11 * 32]); o.w = pk4_fp8(s[12 * 32], s[13 * 32], s[14 * 32], s[15 * 32]);
            *(GAS v4u*)(t.dst + (size_t)n * t.dstKb + 16 * c) = o; }
    }
    LDS_WAIT(); asm volatile("" ::: "memory");
}
constexpr int TI_E1 = 8 * 32 * 224, TI_E2 = 8 * 112 * 64, TI_IN = 32 * 176, TI_O = 32 * 64, TI_F1 = 32 * 176, TI_F2 = 88 * 64, TI_QKV = 32 * 192;
constexpr int TI_N = 2 * TI_E1 + TI_E2 + TI_IN + 2 * TI_O + 2 * TI_F1 + TI_F2 + TI_QKV;
__device__ __forceinline__ TrItem tr_decode(Frame& F, int r) {
    TrItem t; t.valid = 1; t.kind = 0; t.scale = 1.f;
    if (r < 2 * TI_E1) { const int w3 = r >= TI_E1; if (w3) r -= TI_E1; const int e = r / (32 * 224), rr = r % (32 * 224), kb = 2 * (rr / 448) + (rr & 1), n0 = 32 * ((rr % 448) >> 1);
        t.src = (w3 ? KIN(42) : KIN(41)) + ((size_t)e * 2048 + 64 * kb) * 7168 + n0; t.ldsrc = 7168; t.kind = 1; t.scale = SC_W13;
        t.dst = WSP(unsigned char, W_E13) + ((size_t)e * 14336 + gate_up_row(n0) + 128 * w3) * 2048 + 64 * kb; t.dstKb = 2048; return t; } r -= 2 * TI_E1;
    if (r < TI_E2) { const int e = r / (112 * 64), rr = r % (112 * 64), kb = 2 * (rr / 128) + (rr & 1), n0 = 32 * ((rr % 128) >> 1);
        t.src = KIN(43) + ((size_t)e * 7168 + 64 * kb) * 2048 + n0; t.ldsrc = 2048; t.kind = 1; t.scale = SC_W2;
        t.dst = WSP(unsigned char, W_E2) + ((size_t)e * 2048 + n0) * 7168 + 64 * kb; t.dstKb = 7168; return t; } r -= TI_E2;
    if (r < TI_IN) { const int kb = r / 176, n0 = 32 * (r % 176);
        t.src = KIN(8) + (size_t)(64 * kb) * NIN + n0; t.ldsrc = NIN; t.valid = n0 < NIN;
#ifdef IN_F8
        t.kind = 1; t.scale = SC_W13; t.dst = WSP(unsigned char, W_WIN) + (size_t)n0 * 2048 + 64 * kb; t.dstKb = 2048; return t; } r -= TI_IN;
#else
        t.dst = WSP(unsigned char, W_WIN) + ((size_t)n0 * 2048 + 64 * kb) * 2; t.dstKb = 4096; return t; } r -= TI_IN;
#endif
    if (r < TI_O) { const int kb = r / 64, n0 = 32 * (r % 64);
        t.src = KIN(23) + (size_t)(64 * kb) * 2048 + n0; t.ldsrc = 2048;
#ifdef WO0_F8
        t.kind = 1; t.scale = SC_W13; t.dst = WSP(unsigned char, W_WO0) + (size_t)n0 * 4096 + 64 * kb; t.dstKb = 4096; return t; } r -= TI_O;
#else
        t.dst = WSP(unsigned char, W_WO0) + ((size_t)n0 * 2048 + 64 * kb) * 2; t.dstKb = 4096; return t; } r -= TI_O;
#endif
    if (r < 2 * TI_F1) { const int w3 = r >= TI_F1; if (w3) r -= TI_F1; const int kb = r / 176, n0 = 32 * (r % 176);
        t.src = (w3 ? KIN(25) : KIN(24)) + (size_t)(64 * kb) * FF + n0; t.ldsrc = FF;
#ifdef F13_F8
        t.kind = 1; t.scale = SC_W13; t.dst = WSP(unsigned char, W_W13) + (size_t)(gate_up_row(n0) + 128 * w3) * 2048 + 64 * kb; t.dstKb = 2048; return t; } r -= 2 * TI_F1;
#else
        t.dst = WSP(unsigned char, W_W13) + ((size_t)(gate_up_row(n0) + 128 * w3) * 2048 + 64 * kb) * 2; t.dstKb = 4096; return t; } r -= 2 * TI_F1;
#endif
    if (r < TI_F2) { const int kb = r / 64, n0 = 32 * (r % 64);
        t.src = KIN(26) + (size_t)(64 * kb) * 2048 + n0; t.ldsrc = 2048;
#ifdef F2_BF16
        t.dst = WSP(unsigned char, W_W2) + ((size_t)n0 * FF + 64 * kb) * 2; t.dstKb = 2 * FF; return t; } r -= TI_F2;
#else
        t.kind = 1; t.scale = SC_W2; t.dst = WSP(unsigned char, W_W2) + (size_t)n0 * FF + 64 * kb; t.dstKb = FF; return t; } r -= TI_F2;
#endif
    if (r < TI_QKV) { const int kb = r / 192, n0 = 32 * (r % 192);
        t.src = KIN(31) + (size_t)(64 * kb) * 6144 + n0; t.ldsrc = 6144;
#ifdef QKV_F8
        t.kind = 1; t.scale = SC_W13; t.dst = WSP(unsigned char, W_QKV) + (size_t)n0 * 2048 + 64 * kb; t.dstKb = 2048; return t; } r -= TI_QKV;
#else
        t.dst = WSP(unsigned char, W_QKV) + ((size_t)n0 * 2048 + 64 * kb) * 2; t.dstKb = 4096; return t; } r -= TI_QKV;
#endif
    { const int kb = r / 64, n0 = 32 * (r % 64);
        t.src = KIN(39) + (size_t)(64 * kb) * 2048 + n0; t.ldsrc = 2048;
#ifdef WO1_F8
        t.kind = 1; t.scale = SC_W13; t.dst = WSP(unsigned char, W_WO1) + (size_t)n0 * 2048 + 64 * kb; t.dstKb = 2048; return t; }
#else
        t.dst = WSP(unsigned char, W_WO1) + ((size_t)n0 * 2048 + 64 * kb) * 2; t.dstKb = 4096; return t; }
#endif
}
constexpr int TI_NQ = 2 * TI_E1 + TI_E2;
__device__ __forceinline__ void convert_items(Frame& F, int first, int count, LAS float* scr) {
    TrItem cur = tr_decode(F, first); f32x4 vc[8]; tr_load(cur, vc, F.lane);
#pragma unroll 1
    for (int i = 0; i < count; ++i) {
        const bool more = i + 1 < count;
        TrItem nxt = cur; f32x4 vn[8];
        if (more) { nxt = tr_decode(F, first + i + 1); tr_load(nxt, vn, F.lane); }
        tr_store(cur, vc, scr, F.lane);
        if (more) {
#pragma unroll
            for (int j = 0; j < 8; ++j) vc[j] = vn[j];
            cur = nxt; }
    }
}
__device__ __forceinline__ void convert_queue(Frame& F, int done_slot, unsigned need) {
#ifndef QGRAB
#define QGRAB 2
#endif
    constexpr int SH = TI_NQ / 8, GRAB = QGRAB; static_assert(TI_NQ % 8 == 0 && SH % GRAB == 0, "queue shards");
    const int shard = blockIdx.x & 7;
    for (;;) {
        unsigned q = 0;
        if (F.lane == 0) q = __hip_atomic_fetch_add(F.ctl + CW_CQ + 64 * shard, (unsigned)GRAB, __ATOMIC_RELAXED, __HIP_MEMORY_SCOPE_AGENT);
        q = (unsigned)__builtin_amdgcn_readfirstlane((int)q);
        if (q >= (unsigned)SH) break;
        convert_items(F, shard * SH + (int)q, min(GRAB, SH - (int)q), (LAS float*)(F.lds + F.wave * 8192));
        if (need) { unsigned d = 0; if (F.lane == 0) d = __hip_atomic_load(F.ctl + CW_DONE + 64 * done_slot, __ATOMIC_RELAXED, __HIP_MEMORY_SCOPE_AGENT); d = (unsigned)__builtin_amdgcn_readfirstlane((int)d); if (d >= need) break; }
    }
}
__device__ __forceinline__ void convert_grab(Frame& F, LAS float* scr) {
    constexpr int SH = TI_NQ / 8, GRAB = 2;
    const int shard = blockIdx.x & 7;
    unsigned q = 0;
    if (F.lane == 0) q = __hip_atomic_fetch_add(F.ctl + CW_CQ + 64 * shard, (unsigned)GRAB, __ATOMIC_RELAXED, __HIP_MEMORY_SCOPE_AGENT);
    q = (unsigned)__builtin_amdgcn_readfirstlane((int)q);
    if (q < (unsigned)SH) {
#pragma unroll 1
        for (int i = 0; i < GRAB; ++i) { const TrItem t = tr_decode(F, shard * SH + (int)q + i); f32x4 v[8]; tr_load(t, v, F.lane); __builtin_amdgcn_s_waitcnt(0x0F70); tr_store(t, v, scr, F.lane); } }
}
__device__ __forceinline__ void fill_tail(Frame& F, int done_slot, int nwg) {
    const int R = nwg % F.G; if (R == 0) return;
    if ((int)blockIdx.x < R) { if (F.tid == 0) __hip_atomic_fetch_add(F.ctl + CW_DONE + 64 * done_slot, 1u, __ATOMIC_RELAXED, __HIP_MEMORY_SCOPE_AGENT); }
    else if (F.wave < 4) convert_queue(F, done_slot, (unsigned)R);
}
__device__ __forceinline__ void p0_transposes(Frame& F) {
    LAS float* scr = (LAS float*)(F.lds + F.wave * 8192);
    const int gw = blockIdx.x * NWAVES + F.wave, NGW = F.G * NWAVES;
    int it = TI_NQ + gw;
    if (it < TI_N) {
        TrItem cur = tr_decode(F, it); f32x4 vc[8]; tr_load(cur, vc, F.lane);
#pragma unroll 1
        for (;;) {
            const int nx = it + NGW; const bool more = nx < TI_N;
            TrItem nxt = cur; f32x4 vn[8];
            if (more) { nxt = tr_decode(F, nx); tr_load(nxt, vn, F.lane); }
            tr_store(cur, vc, scr, F.lane);
            if (!more) break;
#pragma unroll
            for (int i = 0; i < 8; ++i) vc[i] = vn[i];
            cur = nxt; it = nx;
        }
    }
    bf16* WUPT = WSP(bf16, WS_SMALLW); bf16* AUPT = WUPT + 2 * 1024 * 64; bf16* GUPT = AUPT + 2 * 1024 * 64;
    const int gt = blockIdx.x * 512 + F.tid, NGT = F.G * 512;
    for (int i = gt; i < 2 * 65536; i += NGT) { const int d = i >> 16, n = (i >> 6) & 1023, k = i & 63;
        WUPT[i] = (bf16)f2bf(KIN(14)[(size_t)d * 65536 + k * 1024 + n]); AUPT[i] = (bf16)f2bf(KIN(16)[(size_t)d * 65536 + k * 1024 + n]); }
    for (int i = gt; i < 1024 * 160; i += NGT) { const int n = i / 160, k = i % 160; GUPT[i] = (bf16)f2bf(KIN(17)[(size_t)k * 1024 + n]); }
}
__device__ __forceinline__ void p0_ada(Frame& F) {
    LAS float* tab = (LAS float*)F.lds;
    LAS float* red = (LAS float*)(F.lds + 80 * 1024);
    for (int i = F.tid; i < 9 * 2048; i += 512) { const int m = i >> 11, k = i & 2047; const float c = m < 8 ? KIN(1)[m * 2048 + k] : KIN(3)[k]; tab[i] = c / (1.0f + expf(-c)); }
    __syncthreads();
    float* MOD = WSP(float, WS_MOD);
    const int q = F.tid & 7, kl = F.tid >> 3;
    for (int u = blockIdx.x; u < 768; u += F.G) {
        const int layer = u / 384, col0 = (u % 384) * 32;
        const float* W = layer ? KIN(27) : KIN(4); const float* bias = layer ? KIN(28) : KIN(5);
        float acc[9][4];
#pragma unroll
        for (int m = 0; m < 9; ++m)
#pragma unroll
            for (int j = 0; j < 4; ++j) acc[m][j] = 0.f;
#pragma unroll 8
        for (int i = 0; i < 32; ++i) { const int k = kl + 64 * i; const f32x4 w = *(const f32x4*)(W + (size_t)k * 12288 + col0 + 4 * q);
#pragma unroll
            for (int m = 0; m < 9; ++m) { const float s = tab[m * 2048 + k];
#pragma unroll
                for (int j = 0; j < 4; ++j) acc[m][j] += s * w[j]; } }
#pragma unroll
        for (int m = 0; m < 9; ++m)
#pragma unroll
            for (int j = 0; j < 4; ++j) { float v = acc[m][j]; v += __shfl_xor(v, 8); v += __shfl_xor(v, 16); v += __shfl_xor(v, 32); if (F.lane < 8) red[(F.wave * 8 + q) * 36 + m * 4 + j] = v; }
        __syncthreads();
        if (F.tid < 288) { const int m = F.tid >> 5, c = F.tid & 31, qq = c >> 2, j = c & 3; float s = 0.f;
#pragma unroll
            for (int w = 0; w < 8; ++w) s += red[(w * 8 + qq) * 36 + m * 4 + j];
            MOD[((size_t)layer * 9 + m) * 12288 + col0 + c] = s + bias[col0 + c]; }
        __syncthreads();
    }
}
template <bool FP8OUT = false>
__device__ __forceinline__ void norm_mod_rows(Frame& F, const float* xl, const float* xc, const float* g, const float* modl, int s_shift, int s_scale, bf16* out, int nrows) {
    const int gw = blockIdx.x * NWAVES + F.wave, NGW = F.G * NWAVES;
    const int per = (nrows + NGW - 1) / NGW, r0 = gw * per, r1 = min(nrows, r0 + per);
    if (r0 >= r1) return;
    f32x4 gm[8], hm[8];
#define NM_SRC(r) ((const f32x4*)((r) < RL ? xl + (size_t)(r) * D : xc + (size_t)((r) - RL) * D))
#define NM_LOAD(v, r) do { const f32x4* s_ = NM_SRC(r); _Pragma("unroll") for (int j = 0; j < 8; ++j) v[j] = s_[F.lane + 64 * j]; asm volatile("" ::: "memory"); __builtin_amdgcn_sched_barrier(0); } while (0)
#define NM_ROW(v, r) do { float ss = 0.f;                                                                                                                    \
        _Pragma("unroll") for (int j = 0; j < 8; ++j) ss += (v[j].x * v[j].x + v[j].y * v[j].y) + (v[j].z * v[j].z + v[j].w * v[j].w);                        \
        const float rstd = 1.0f / sqrtf(wave_sum(ss) * (1.0f / D) + 1e-6f);                                                                                  \
        v2u* o8 = (v2u*)(out + (size_t)(r) * D); unsigned* o4 = (unsigned*)((unsigned char*)out + (size_t)(r) * D);                                          \
        _Pragma("unroll") for (int j = 0; j < 8; ++j) { const f32x4 y = v[j] * rstd * gm[j] + hm[j];                                                          \
            if (FP8OUT) o4[F.lane + 64 * j] = pk4_fp8(y.x * SC_A8, y.y * SC_A8, y.z * SC_A8, y.w * SC_A8);                                                   \
            else { v2u w; w.x = pk2(y.x, y.y); w.y = pk2(y.z, y.w); o8[F.lane + 64 * j] = w; } }                                                             \
        asm volatile("" ::: "memory"); __builtin_amdgcn_sched_barrier(0); } while (0)
    for (int s0 = r0; s0 < r1;) {
        const int mrow = s0 < RL ? (s0 >> 11) : 8, send = min(r1, mrow < 8 ? (mrow + 1) << 11 : nrows);
        { const f32x4* sh = (const f32x4*)(modl + (size_t)mrow * 12288 + s_shift * 2048); const f32x4* sc = (const f32x4*)(modl + (size_t)mrow * 12288 + s_scale * 2048);
#pragma unroll
          for (int j = 0; j < 8; ++j) { const int c4 = F.lane + 64 * j; gm[j] = ((const f32x4*)g)[c4] * (sc[c4] + 1.0f); hm[j] = sh[c4]; } }
        __builtin_amdgcn_s_waitcnt(0x0F70);
        f32x4 va[8], vb[8];
        NM_LOAD(va, s0);
        __builtin_amdgcn_s_waitcnt(0x0F70);
#pragma unroll 1
        for (int r = s0; r < send; r += 2) {
            __builtin_amdgcn_s_waitcnt(0x0F78);
            if (r + 1 < send) NM_LOAD(vb, r + 1);
            NM_ROW(va, r);
            if (r + 1 < send) { __builtin_amdgcn_s_waitcnt(0x0F78); if (r + 2 < send) NM_LOAD(va, r + 2); NM_ROW(vb, r + 1); }
        }
        __builtin_amdgcn_s_waitcnt(0x0F70);
        s0 = send;
    }
#undef NM_SRC
#undef NM_LOAD
#undef NM_ROW
}
__device__ __forceinline__ void copy_rows(Frame& F, const float* src, float* dst, size_t n4) {
    const size_t gt = (size_t)blockIdx.x * 512 + F.tid, NGT = (size_t)F.G * 512;
#ifdef PROBE_ST8
    for (size_t i = gt; i < n4; i += NGT) { const f32x4 v = ((const f32x4*)src)[i]; const size_t w_ = i >> 6, l_ = i & 63; v2u* d = (v2u*)((f32x4*)dst + w_ * 64);
        d[l_] = (v2u){__builtin_bit_cast(unsigned, v.x), __builtin_bit_cast(unsigned, v.y)}; d[64 + l_] = (v2u){__builtin_bit_cast(unsigned, v.z), __builtin_bit_cast(unsigned, v.w)}; }
#else
    for (size_t i = gt; i < n4; i += NGT) ((f32x4*)dst)[i] = ((const f32x4*)src)[i];
#endif
}

constexpr size_t FE_R = 0, FE_KK = 1, FE_V = 2, FE_K = 3, FE_E0 = 4, FE_A0 = 5;
constexpr size_t WS_YD = WS_ACTC + 9 * FEAT_SZ;
static_assert(WS_YD + (size_t)2 * RT * 1024 * 4 <= WS_ACTC + 476 * MiB, "YD fits");
#define FEAT(i) ((bf16*)(F.ws + WS_ACTC + (size_t)(i) * FEAT_SZ))

__device__ __forceinline__ void unpack8(const v4u& w, float (&f)[8]) {
    f[0] = bflo(w.x); f[1] = bfhi(w.x); f[2] = bflo(w.y); f[3] = bfhi(w.y); f[4] = bflo(w.z); f[5] = bfhi(w.z); f[6] = bflo(w.w); f[7] = bfhi(w.w);
}
__device__ __forceinline__ v4u pack8(const float (&f)[8]) { v4u w; w.x = pk2(f[0], f[1]); w.y = pk2(f[2], f[3]); w.z = pk2(f[4], f[5]); w.w = pk2(f[6], f[7]); return w; }

__device__ __forceinline__ void sgu_unit(Frame& F, int u, const bf16* HL, bf16* AB) {
    constexpr int LQ = 136;
    LAS bf16* vt = (LAS bf16*)F.lds;
    const int chunk = u >> 3, g = u & 7, row0 = chunk * 128;
    {
        const int q = F.tid >> 2, part = F.tid & 3;
        const bf16* vp = HL + (size_t)(row0 + q) * NINP + 1024 + g * 128 + part * 32;
        float x[32]; float ss = 0.f;
#pragma unroll
        for (int k = 0; k < 4; ++k) { const v4u w = *(const v4u*)(vp + 8 * k); float f[8]; unpack8(w, f);
#pragma unroll
            for (int e = 0; e < 8; ++e) { x[8 * k + e] = f[e]; ss += f[e] * f[e]; } }
        ss += __shfl_xor(ss, 1); ss += __shfl_xor(ss, 2);
        const float rstd = 1.0f / sqrtf(ss * (1.0f / 128.0f) + 1e-6f);
        const float* ng = KIN(9) + g * 128 + part * 32;
#pragma unroll
        for (int e = 0; e < 32; ++e) vt[(part * 32 + e) * LQ + q] = (bf16)f2bf(x[e] * rstd * ng[e]);
    }
    __syncthreads();
    {
        const int l15 = F.lane & 15, lq = F.lane >> 4, p = 16 * F.wave + l15;
        const float* wrow = KIN(10) + ((size_t)g * 128 + p) * 128;
        bf16x8 wfr[4];
#pragma unroll
        for (int ks = 0; ks < 4; ++ks) { const f32x4 a = *(const f32x4*)(wrow + 32 * ks + 8 * lq), b = *(const f32x4*)(wrow + 32 * ks + 8 * lq + 4);
            v4u w; w.x = pk2(a.x, a.y); w.y = pk2(a.z, a.w); w.z = pk2(b.x, b.y); w.w = pk2(b.z, b.w); wfr[ks] = __builtin_bit_cast(bf16x8, w); }
        const float bsp = KIN(11)[g * 128 + p];
        const bf16* urow = HL + (size_t)(row0 + p) * NINP + g * 128; bf16* orow = AB + (size_t)(row0 + p) * D + g * 128;
#pragma unroll
        for (int ct = 0; ct < 8; ++ct) {
            f32x4 acc = {0.f, 0.f, 0.f, 0.f};
#pragma unroll
            for (int ks = 0; ks < 4; ++ks) { const bf16x8 vf = *(const LAS bf16x8*)(vt + (16 * ct + l15) * LQ + 32 * ks + 8 * lq);
                acc = __builtin_amdgcn_mfma_f32_16x16x32_bf16(vf, wfr[ks], acc, 0, 0, 0); }
            const int c = 16 * ct + 4 * lq; const v2u uw = *(const v2u*)(urow + c);
#ifdef WO0_F8
            *(unsigned*)((unsigned char*)AB + (size_t)(row0 + p) * (2 * D) + g * 128 + c) = pk4_fp8(SC_A8 * bflo(uw.x) * (acc[0] + bsp), SC_A8 * bfhi(uw.x) * (acc[1] + bsp), SC_A8 * bflo(uw.y) * (acc[2] + bsp), SC_A8 * bfhi(uw.y) * (acc[3] + bsp));
            (void)orow;
#else
            v2u o; o.x = pk2(bflo(uw.x) * (acc[0] + bsp), bfhi(uw.x) * (acc[1] + bsp)); o.y = pk2(bflo(uw.y) * (acc[2] + bsp), bfhi(uw.y) * (acc[3] + bsp));
            *(v2u*)(orow + c) = o;
#endif
        }
    }
    __syncthreads();
}

constexpr int FT = 32, FNR = FT / 8;
__device__ __forceinline__ void feat_unit(Frame& F, int u, const bf16* HL, bf16* AB) {
    constexpr int LT = 72, LG = 168;
    LAS bf16* TW = (LAS bf16*)F.lds; LAS bf16* AD = TW + 64 * LT; LAS bf16* SG = AD + 64 * LT;
    const int row0 = u * FT; const bool lat = row0 < RL; const int seqlen = lat ? SEQ : CTX; const int p0 = (lat ? row0 : row0 - RL) & (seqlen - 1);
    bf16* Rr = FEAT(FE_R); bf16* KKr = FEAT(FE_KK); bf16* Vr = FEAT(FE_V); bf16* Kt = FEAT(FE_K);
    {
        const int lr0 = FNR * F.wave;
        const float* const kkbase = KIN(18);
        v4u zn[FNR + 2]; f32x4 wn[6];
        const float* const swp = KIN(12);
#define F1_LOADZ(ii, dst) do { const bool act_ = ((ii) < 6) || (F.lane < 36); const int ci_ = act_ ? ((ii) < 6 ? F.lane + 64 * (ii) : 384 + F.lane) : 0; \
            _Pragma("unroll") for (int jj = 0; jj < FNR + 2; ++jj) { const int pos = p0 + lr0 - 1 + jj; const bool ok = pos >= 0 && pos < seqlen; \
                dst[jj] = ok ? *(const v4u*)(HL + (size_t)(row0 + lr0 - 1 + jj) * NINP + ZB + 8 * ci_) : (v4u){0u, 0u, 0u, 0u}; } \
            { const float* sw_ = swp + 8 * ci_; wn[0] = *(const f32x4*)sw_; wn[1] = *(const f32x4*)(sw_ + 4); wn[2] = *(const f32x4*)(sw_ + 3360); wn[3] = *(const f32x4*)(sw_ + 3364); wn[4] = *(const f32x4*)(sw_ + 6720); wn[5] = *(const f32x4*)(sw_ + 6724); } } while (0)
        F1_LOADZ(0, zn);
#pragma unroll 1
        for (int i = 0; i < 7; ++i) {
            const bool active = (i < 6) || (F.lane < 36);
            const int ci = active ? (i < 6 ? F.lane + 64 * i : 384 + F.lane) : 0, col = 8 * ci;
            float w0[8], w1[8], w2[8];
            { const f32x4 a = wn[0], b = wn[1], c = wn[2], d = wn[3], e = wn[4], f = wn[5];
              w0[0] = a.x; w0[1] = a.y; w0[2] = a.z; w0[3] = a.w; w0[4] = b.x; w0[5] = b.y; w0[6] = b.z; w0[7] = b.w;
              w1[0] = c.x; w1[1] = c.y; w1[2] = c.z; w1[3] = c.w; w1[4] = d.x; w1[5] = d.y; w1[6] = d.z; w1[7] = d.w;
              w2[0] = e.x; w2[1] = e.y; w2[2] = e.z; w2[3] = e.w; w2[4] = f.x; w2[5] = f.y; w2[6] = f.z; w2[7] = f.w; }
            v4u z[FNR + 2];
#pragma unroll
            for (int jj = 0; jj < FNR + 2; ++jj) z[jj] = zn[jj];
            if (i + 1 < 7) F1_LOADZ(i + 1, zn);
#pragma unroll
            for (int j = 0; j < FNR; ++j) {
                float za[8], zb[8], zc[8], zs[8]; unpack8(z[j], za); unpack8(z[j + 1], zb); unpack8(z[j + 2], zc);
#pragma unroll
                for (int e = 0; e < 8; ++e) zs[e] = w0[e] * za[e] + w1[e] * zb[e] + w2[e] * zc[e];
                const int tok = lr0 + j; const size_t row = (size_t)(row0 + tok);
                if (i < 2) { *(v4u*)(Rr + row * 1024 + col) = pack8(zs); }
                else if (i < 4) { const int c1 = col - 1024; const float* kkp = kkbase + c1; float kr[8]; float ss = 0.f;
#pragma unroll
                    for (int e = 0; e < 8; ++e) { kr[e] = zs[e] * kkp[e]; ss += kr[e] * kr[e]; }
                    ss += __shfl_xor(ss, 1); ss += __shfl_xor(ss, 2); ss += __shfl_xor(ss, 4);
                    const float inv = 1.0f / fmaxf(sqrtf(ss), 1e-12f);
#pragma unroll
                    for (int e = 0; e < 8; ++e) kr[e] *= inv;
                    *(v4u*)(KKr + row * 1024 + c1) = pack8(kr); *(v4u*)(Kt + row * 1024 + c1) = pack8(zs); }
                else if (i < 6) { *(v4u*)(Vr + row * 1024 + (col - 2048)) = pack8(zs); }
                else if (active) {
                    if (F.lane < 8) { float t[8];
#pragma unroll
                        for (int e = 0; e < 8; ++e) t[e] = 2.0f * fast_sigmoid(2.0f * zs[e]) - 1.0f;
                        *(LAS v4u*)(TW + tok * LT + 8 * F.lane) = pack8(t); }
                    else if (F.lane < 16) { *(LAS v4u*)(AD + tok * LT + 8 * (F.lane - 8)) = pack8(zs); }
                    else { float t[8];
#pragma unroll
                        for (int e = 0; e < 8; ++e) t[e] = fast_sigmoid(zs[e]);
                        *(LAS v4u*)(SG + tok * LG + 8 * (F.lane - 16)) = pack8(t); }
                }
            }
        }
    }
    __syncthreads();
    {
        constexpr int ORS = 272, OAS = 64 * ORS;
        LAS unsigned char* OUT = F.lds + 40 * 1024;
        const int l15 = F.lane & 15, lq = F.lane >> 4;
        const bf16* WUPT = WSP(bf16, WS_SMALLW); const bf16* AUPT = WUPT + 2 * 1024 * 64; const bf16* GUPT = AUPT + 2 * 1024 * 64;
        const float* const pw0 = KIN(13); const float* const pa0 = KIN(15);
        {
            bf16x8 gn[5];
#define F2_LOADG(p_) do { const int nl_ = 128 * (p_) + 16 * F.wave + l15; _Pragma("unroll") for (int ks = 0; ks < 5; ++ks) gn[ks] = *(const bf16x8*)(GUPT + (size_t)nl_ * 160 + 32 * ks + 8 * lq); } while (0)
            F2_LOADG(0);
#pragma unroll 1
            for (int p = 0; p < 8; ++p) {
                bf16x8 fg[5];
#pragma unroll
                for (int ks = 0; ks < 5; ++ks) fg[ks] = gn[ks];
                if (p + 1 < 8) F2_LOADG(p + 1);
#pragma unroll
                for (int mt = 0; mt < FT / 16; ++mt) { const int tok = 16 * mt + l15; f32x4 ag = {0.f, 0.f, 0.f, 0.f};
#pragma unroll
                    for (int ks = 0; ks < 5; ++ks) { const bf16x8 xg = *(const LAS bf16x8*)(SG + tok * LG + 32 * ks + 8 * lq); ag = __builtin_amdgcn_mfma_f32_16x16x32_bf16(fg[ks], xg, ag, 0, 0, 0); }
                    v2u w_; w_.x = pk2(ag[0], ag[1]); w_.y = pk2(ag[2], ag[3]); *(LAS v2u*)(OUT + tok * ORS + (16 * F.wave + 4 * lq) * 2) = w_; }
                __syncthreads();
#pragma unroll
                for (int i = 0; i < FT / 32; ++i) { const int q = F.tid + 512 * i, row = q >> 4, c16 = q & 15;
                    *(v4u*)(AB + (size_t)(row0 + row) * D + 1024 + 128 * p + 8 * c16) = *(const LAS v4u*)(OUT + row * ORS + c16 * 16); }
                __syncthreads();
            }
#undef F2_LOADG
        }
        struct F2L { bf16x8 fw[2][2], fa[2][2]; f32x4 cw0, cw1, ca0, ca1; };
#define F2_LOAD(L, p_) do { const int n0_ = 128 * (p_) + 16 * F.wave, nl_ = n0_ + l15, nn_ = n0_ + 4 * lq; \
            _Pragma("unroll") for (int d = 0; d < 2; ++d) _Pragma("unroll") for (int ks = 0; ks < 2; ++ks) { L.fw[d][ks] = *(const bf16x8*)(WUPT + ((size_t)d * 1024 + nl_) * 64 + 32 * ks + 8 * lq); L.fa[d][ks] = *(const bf16x8*)(AUPT + ((size_t)d * 1024 + nl_) * 64 + 32 * ks + 8 * lq); } \
            L.cw0 = *(const f32x4*)(pw0 + nn_); L.cw1 = *(const f32x4*)(pw0 + 1024 + nn_); L.ca0 = *(const f32x4*)(pa0 + nn_); L.ca1 = *(const f32x4*)(pa0 + 1024 + nn_); } while (0)
        F2L nx; F2_LOAD(nx, 0);
#pragma unroll 1
        for (int p = 0; p < 8; ++p) {
            const F2L cu = nx;
            if (p + 1 < 8) F2_LOAD(nx, p + 1);
#pragma unroll 1
            for (int mt = 0; mt < FT / 16; ++mt) {
                const int tok = 16 * mt + l15;
                f32x4 aw0 = cu.cw0, aw1 = cu.cw1, aa0 = cu.ca0, aa1 = cu.ca1;
#pragma unroll
                for (int ks = 0; ks < 2; ++ks) { const bf16x8 xt = *(const LAS bf16x8*)(TW + tok * LT + 32 * ks + 8 * lq), xa = *(const LAS bf16x8*)(AD + tok * LT + 32 * ks + 8 * lq);
                    aw0 = __builtin_amdgcn_mfma_f32_16x16x32_bf16(cu.fw[0][ks], xt, aw0, 0, 0, 0); aw1 = __builtin_amdgcn_mfma_f32_16x16x32_bf16(cu.fw[1][ks], xt, aw1, 0, 0, 0);
                    aa0 = __builtin_amdgcn_mfma_f32_16x16x32_bf16(cu.fa[0][ks], xa, aa0, 0, 0, 0); aa1 = __builtin_amdgcn_mfma_f32_16x16x32_bf16(cu.fa[1][ks], xa, aa1, 0, 0, 0); }
                float e0[4], e1[4], a0[4], a1[4];
#pragma unroll
                for (int r = 0; r < 4; ++r) { e0[r] = 0.6065306597126334f * fast_sigmoid(aw0[r]); e1[r] = 0.6065306597126334f * fast_sigmoid(aw1[r]); a0[r] = fast_sigmoid(aa0[r]); a1[r] = fast_sigmoid(aa1[r]); }
                LAS unsigned char* op = OUT + tok * ORS + (16 * F.wave + 4 * lq) * 2;
#define STL(ai, VV) do { v2u w_; w_[0] = pk2(VV[0], VV[1]); w_[1] = pk2(VV[2], VV[3]); *(LAS v2u*)(op + (ai) * OAS) = w_; } while (0)
                STL(0, e0); STL(1, a0); STL(2, e1); STL(3, a1);
#undef STL
            }
            __syncthreads();
#pragma unroll
            for (int i = 0; i < FT / 32; ++i) { const int q = F.tid + 512 * i, row = q >> 4, c16 = q & 15; const size_t grow = (size_t)(row0 + row);
#pragma unroll
                for (int ai = 0; ai < 4; ++ai) *(v4u*)(FEAT(FE_E0 + ai) + grow * 1024 + 128 * p + 8 * c16) = *(const LAS v4u*)(OUT + ai * OAS + row * ORS + c16 * 16); }
            __syncthreads();
        }
#undef F2_LOAD
    }
}

template <int CTRL> __device__ __forceinline__ float dpp_add(float x) { return x + __builtin_bit_cast(float, __builtin_amdgcn_update_dpp(0, __builtin_bit_cast(int, x), CTRL, 0xf, 0xf, true)); }
__device__ __forceinline__ float red16(float x) { x = dpp_add<0xB1>(x); x = dpp_add<0x4E>(x); x = dpp_add<0x141>(x); x = dpp_add<0x140>(x); return x; }
__device__ __forceinline__ void red16x4(float& a, float& b, float& c, float& d) {
    asm volatile("s_nop 1\n\t"
        "v_add_f32_dpp %0, %0, %0 quad_perm:[1,0,3,2] row_mask:0xf bank_mask:0xf\n\tv_add_f32_dpp %1, %1, %1 quad_perm:[1,0,3,2] row_mask:0xf bank_mask:0xf\n\t"
        "v_add_f32_dpp %2, %2, %2 quad_perm:[1,0,3,2] row_mask:0xf bank_mask:0xf\n\tv_add_f32_dpp %3, %3, %3 quad_perm:[1,0,3,2] row_mask:0xf bank_mask:0xf\n\t"
        "v_add_f32_dpp %0, %0, %0 quad_perm:[2,3,0,1] row_mask:0xf bank_mask:0xf\n\tv_add_f32_dpp %1, %1, %1 quad_perm:[2,3,0,1] row_mask:0xf bank_mask:0xf\n\t"
        "v_add_f32_dpp %2, %2, %2 quad_perm:[2,3,0,1] row_mask:0xf bank_mask:0xf\n\tv_add_f32_dpp %3, %3, %3 quad_perm:[2,3,0,1] row_mask:0xf bank_mask:0xf\n\t"
        "v_add_f32_dpp %0, %0, %0 row_half_mirror row_mask:0xf bank_mask:0xf\n\tv_add_f32_dpp %1, %1, %1 row_half_mirror row_mask:0xf bank_mask:0xf\n\t"
        "v_add_f32_dpp %2, %2, %2 row_half_mirror row_mask:0xf bank_mask:0xf\n\tv_add_f32_dpp %3, %3, %3 row_half_mirror row_mask:0xf bank_mask:0xf\n\t"
        "v_add_f32_dpp %0, %0, %0 row_mirror row_mask:0xf bank_mask:0xf\n\tv_add_f32_dpp %1, %1, %1 row_mirror row_mask:0xf bank_mask:0xf\n\t"
        "v_add_f32_dpp %2, %2, %2 row_mirror row_mask:0xf bank_mask:0xf\n\tv_add_f32_dpp %3, %3, %3 row_mirror row_mask:0xf bank_mask:0xf\n\t"
        "s_nop 1"
        : "+v"(a), "+v"(b), "+v"(c), "+v"(d));
}
__device__ __forceinline__ int scan_row(int dir, int b, int t) {
    if (t < CTX) return RL + b * CTX + (dir ? CTX - 1 - t : t);
    const int tl = t - CTX; return b * SEQ + (dir ? SEQ - 1 - tl : tl);
}
__device__ __forceinline__ void readout_rows(Frame& F, bf16* AB) {
    const int gw = __builtin_amdgcn_readfirstlane(blockIdx.x * NWAVES + F.wave), NH = (F.G * NWAVES) >> 1, half = gw & 1, gh = gw >> 1;
    const float* Y0 = (const float*)(F.ws + WS_YD); const float* Y1 = Y0 + (size_t)RT * 1024;
    const int per = (RT + NH - 1) / NH, r0 = gh * per, r1 = min(RT, r0 + per);
    if (r0 >= r1) return;
    const int n0 = half * 512 + 8 * F.lane;
    float ka[8], rk[8], lw[8], lb[8];
#pragma unroll
    for (int e = 0; e < 8; ++e) { ka[e] = KIN(19)[n0 + e]; rk[e] = KIN(20)[n0 + e]; lw[e] = KIN(21)[n0 + e]; lb[e] = KIN(22)[n0 + e]; }
    __builtin_amdgcn_s_waitcnt(0x0F70);
#define RO_LOAD(B, r_) do { const size_t o = (size_t)(r_) * 1024 + n0; B##y0[0] = *(const f32x4*)(Y0 + o); B##y0[1] = *(const f32x4*)(Y0 + o + 4); B##y1[0] = *(const f32x4*)(Y1 + o); B##y1[1] = *(const f32x4*)(Y1 + o + 4); \
        B##r = *(const v4u*)(FEAT(FE_R) + o); B##k = *(const v4u*)(FEAT(FE_K) + o); B##a0 = *(const v4u*)(FEAT(FE_A0) + o); B##a1 = *(const v4u*)(FEAT(FE_A0 + 2) + o); B##v = *(const v4u*)(FEAT(FE_V) + o);     \
        B##g = *(const v4u*)(AB + (size_t)(r_) * D + 1024 + n0); asm volatile("" ::: "memory"); __builtin_amdgcn_sched_barrier(0); } while (0)
#define RO_ROW(B, r_) do { float y[8];                                                                                                                         \
        _Pragma("unroll") for (int e = 0; e < 4; ++e) { y[e] = B##y0[0][e] + B##y1[0][e]; y[4 + e] = B##y0[1][e] + B##y1[1][e]; }                                   \
        float s = 0.f;                                                                                                                                             \
        _Pragma("unroll") for (int e = 0; e < 8; ++e) s += y[e];                                                                                                    \
        s += __shfl_xor(s, 1); s += __shfl_xor(s, 2); s += __shfl_xor(s, 4); const float mu = s * (1.0f / 64.0f);                                                  \
        float q = 0.f;                                                                                                                                             \
        _Pragma("unroll") for (int e = 0; e < 8; ++e) { const float d = y[e] - mu; q += d * d; }                                                                    \
        q += __shfl_xor(q, 1); q += __shfl_xor(q, 2); q += __shfl_xor(q, 4); const float rstd = 1.0f / sqrtf(q * (1.0f / 64.0f) + 64e-5f);                          \
        float rr[8], kx[8], a0[8], a1[8], vv[8], gg[8];                                                                                                            \
        unpack8(B##r, rr); unpack8(B##k, kx); unpack8(B##a0, a0); unpack8(B##a1, a1); unpack8(B##v, vv); unpack8(B##g, gg);                                           \
        float bs = 0.f;                                                                          \
        _Pragma("unroll") for (int e = 0; e < 8; ++e) bs += rr[e] * kx[e] * (2.0f + (a0[e] + a1[e] - 2.0f) * ka[e]) * rk[e];                                         \
        bs += __shfl_xor(bs, 1); bs += __shfl_xor(bs, 2); bs += __shfl_xor(bs, 4);                                                                                 \
        float ob[8];                                                                                                                                               \
        _Pragma("unroll") for (int e = 0; e < 8; ++e) ob[e] = ((y[e] - mu) * rstd * lw[e] + lb[e] + bs * vv[e]) * gg[e];                                             \
        RO_STORE(r_); asm volatile("" ::: "memory"); __builtin_amdgcn_sched_barrier(0); } while (0)
#ifdef WO0_F8
#define RO_STORE(r_) do { v2u w_; w_.x = pk4_fp8(SC_A8 * ob[0], SC_A8 * ob[1], SC_A8 * ob[2], SC_A8 * ob[3]); w_.y = pk4_fp8(SC_A8 * ob[4], SC_A8 * ob[5], SC_A8 * ob[6], SC_A8 * ob[7]); *(v2u*)((unsigned char*)AB + (size_t)(r_) * (2 * D) + 1024 + n0) = w_; } while (0)
#else
#define RO_STORE(r_) do { *(v4u*)(AB + (size_t)(r_) * D + 1024 + n0) = pack8(ob); } while (0)
#endif
    f32x4 Ay0[2], Ay1[2], By0[2], By1[2]; v4u Ar, Ak, Aa0, Aa1, Av, Ag, Br, Bk, Ba0, Ba1, Bv, Bg;
    RO_LOAD(A, r0);
    __builtin_amdgcn_s_waitcnt(0x0F70);
#pragma unroll 1
    for (int r = r0; r < r1; r += 2) {
        __builtin_amdgcn_s_waitcnt(0x0F71);
        if (r + 1 < r1) RO_LOAD(B, r + 1);
        RO_ROW(A, r);
        if (r + 1 < r1) { __builtin_amdgcn_s_waitcnt(0x0F71); if (r + 2 < r1) RO_LOAD(A, r + 2); RO_ROW(B, r + 1); }
    }
#undef RO_LOAD
#undef RO_ROW
#undef RO_STORE
}
__device__ __forceinline__ void zero_ab_right(Frame& F, bf16* AB) {
    const size_t gt = (size_t)blockIdx.x * 512 + F.tid, NGT = (size_t)F.G * 512;
    for (size_t i = gt; i < (size_t)RT * 128; i += NGT) { const size_t r = i >> 7, c = (i & 127) * 8; *(v4u*)(AB + r * D + 1024 + c) = (v4u){0u, 0u, 0u, 0u}; }
}

namespace sc2 {
constexpr int C = 16, SLOT = 12544, NSLOT = 8, HS_OFF = SLOT * NSLOT, HS_SZ = 4096, CV_OFF = HS_OFF + 4 * HS_SZ;
constexpr int O_KKT = 0, O_RT = 2048, O_VT = 4096, O_KGT = 6144, O_BGT = 8192, O_Z1 = 10240, O_Z2 = 10752, O_TM = 11264, O_NBR = 11776, O_GC = 12288;
constexpr int H_BT = 0, H_KDT = 2048;
static_assert(CV_OFF + 4 * 8192 <= MISC_OFF && 6 * 2048 <= SLOT, "scan LDS map");
__device__ __forceinline__ f32x4 mfma16(s16x4 a, s16x4 b, f32x4 c) { return __builtin_amdgcn_mfma_f32_16x16x16bf16_1k(a, b, c, 0, 0, 0); }
__device__ __forceinline__ f32x4 mfma32(bf16x8 a, bf16x8 b, f32x4 c) { return __builtin_amdgcn_mfma_f32_16x16x32_bf16(a, b, c, 0, 0, 0); }
__device__ __forceinline__ s16x4 pack4(f32x4 x) { v2u w; w.x = pk2(x[0], x[1]); w.y = pk2(x[2], x[3]); return __builtin_bit_cast(s16x4, w); }
__device__ __forceinline__ f32x4 unpack4(v2u w) { return (f32x4){bflo(w.x), bfhi(w.x), bflo(w.y), bfhi(w.y)}; }
template <int OFF> __device__ __forceinline__ v2u trr(int a) { v2u r; asm volatile("ds_read_b64_tr_b16 %0, %1 offset:%2" : "=&v"(r) : "v"(a), "i"(OFF) : "memory"); return r; }
template <int OFF> __device__ __forceinline__ v2u rd64(int a) { v2u r; asm volatile("ds_read_b64 %0, %1 offset:%2" : "=&v"(r) : "v"(a), "i"(OFF) : "memory"); return r; }
#define TIE4(a, b, c, d) asm volatile("s_waitcnt lgkmcnt(0)" : "+v"(a), "+v"(b), "+v"(c), "+v"(d) :: "memory")
#define TIE1(a) asm volatile("s_waitcnt lgkmcnt(0)" : "+v"(a) :: "memory")
__device__ __forceinline__ bf16x8 cat2(v2u a, v2u b) { const v4u q = {a.x, a.y, b.x, b.y}; return __builtin_bit_cast(bf16x8, q); }
__device__ __forceinline__ s16x4 as4(v2u a) { return __builtin_bit_cast(s16x4, a); }
__device__ __forceinline__ int sw16(int r) { return (((r >> 2) ^ (r >> 3)) & 1) << 4; }

__device__ __forceinline__ void h_load(v4u (&ld)[12], const bf16* const (&arr)[6], int dir, int b, int h, int t0, int lane) {
#pragma unroll
    for (int m = 0; m < 2; ++m) { const int pi = lane + 64 * m, t = pi >> 3, c8 = pi & 7; const size_t ro = (size_t)scan_row(dir, b, t0 + t) * 1024 + h * 64 + c8 * 8;
#pragma unroll
        for (int a = 0; a < 6; ++a) ld[a * 2 + m] = *(const v4u*)(arr[a] + ro); }
}
__device__ __forceinline__ void helper_chunk(v4u (&ld)[12], LAS unsigned char* slot, LAS unsigned char* hs, int lane, float kac) {
    const int l15 = lane & 15, g = lane >> 4, q = (lane >> 2) & 3, p = lane & 3;
    const int sb = (int)(uintptr_t)slot, hb = (int)(uintptr_t)hs;
    { LAS unsigned char* wp = slot + (lane >> 3) * 128 + (((lane & 7) * 16) ^ (((lane >> 4) & 1) * 64));
#pragma unroll
      for (int a = 0; a < 6; ++a) { *(LAS v4u*)(wp + a * 2048) = ld[2 * a]; *(LAS v4u*)(wp + a * 2048 + 1024) = ld[2 * a + 1]; } }
    LDS_WAIT(); asm volatile("" ::: "memory");
    const int rb = sb + q * 128 + ((g * 32 + p * 8) ^ ((q >> 1) * 64));
    v2u re[4], rk[4], ra[4], rkk[4], rr[4], rv[4];
    re[0] = trr<0>(rb); re[1] = trr<512>(rb); re[2] = trr<1024>(rb); re[3] = trr<1536>(rb);
    rkk[0] = trr<2048>(rb); rkk[1] = trr<2048 + 512>(rb); rkk[2] = trr<2048 + 1024>(rb); rkk[3] = trr<2048 + 1536>(rb);
    ra[0] = trr<4096>(rb); ra[1] = trr<4096 + 512>(rb); ra[2] = trr<4096 + 1024>(rb); ra[3] = trr<4096 + 1536>(rb);
    rk[0] = trr<6144>(rb); rk[1] = trr<6144 + 512>(rb); rk[2] = trr<6144 + 1024>(rb); rk[3] = trr<6144 + 1536>(rb);
    rr[0] = trr<8192>(rb); rr[1] = trr<8192 + 512>(rb); rr[2] = trr<8192 + 1024>(rb); rr[3] = trr<8192 + 1536>(rb);
    rv[0] = trr<10240>(rb); rv[1] = trr<10240 + 512>(rb); rv[2] = trr<10240 + 1024>(rb); rv[3] = trr<10240 + 1536>(rb);
    TIE4(re[0], re[1], re[2], re[3]); TIE4(rkk[0], rkk[1], rkk[2], rkk[3]); TIE4(ra[0], ra[1], ra[2], ra[3]); TIE4(rk[0], rk[1], rk[2], rk[3]); TIE4(rr[0], rr[1], rr[2], rr[3]); TIE4(rv[0], rv[1], rv[2], rv[3]);
    const int wo0 = lane * 32 + sw16(lane), wo1 = lane * 32 + (16 ^ sw16(lane));
    float lgs[16];
    { float l = 0.f;
#pragma unroll
      for (int i = 0; i < 4; ++i) { const f32x4 e4 = unpack4(re[i]);
#pragma unroll
          for (int j = 0; j < 4; ++j) { l -= e4[j]; lgs[4 * i + j] = l; } } }
    { const float gC = fast_exp(lgs[15]); float gprev = 1.0f;
      unsigned okk[8], orr[8], ob[8], okd[8], oyb[8], oyk[8];
#pragma unroll
      for (int i = 0; i < 4; ++i) { const f32x4 kk4 = unpack4(rkk[i]), a4 = unpack4(ra[i]), k4 = unpack4(rk[i]), r4 = unpack4(rr[i]);
          float vkk[4], vr[4], vb[4], vkd[4], vyb[4], vyk[4];
#pragma unroll
          for (int j = 0; j < 4; ++j) { const int t = 4 * i + j; const float gt = fast_exp(lgs[t]), ig = __builtin_amdgcn_rcpf(gt), rC = gC * ig, gm = gprev; gprev = gt;
              const float kka = kk4[j] * a4[j], kd = k4[j] * (1.0f + (a4[j] - 1.0f) * kac);
              vkk[j] = kk4[j] * gm; vr[j] = r4[j] * gt; vb[j] = kka * ig; vkd[j] = kd * ig; vyb[j] = -kka * rC; vyk[j] = kd * rC; }
          okk[2 * i] = pk2(vkk[0], vkk[1]); okk[2 * i + 1] = pk2(vkk[2], vkk[3]); orr[2 * i] = pk2(vr[0], vr[1]); orr[2 * i + 1] = pk2(vr[2], vr[3]);
          ob[2 * i] = pk2(vb[0], vb[1]); ob[2 * i + 1] = pk2(vb[2], vb[3]); okd[2 * i] = pk2(vkd[0], vkd[1]); okd[2 * i + 1] = pk2(vkd[2], vkd[3]);
          oyb[2 * i] = pk2(vyb[0], vyb[1]); oyb[2 * i + 1] = pk2(vyb[2], vyb[3]); oyk[2 * i] = pk2(vyk[0], vyk[1]); oyk[2 * i + 1] = pk2(vyk[2], vyk[3]); }
#define ST16S(base, o) do { *(LAS v4u*)((base) + wo0) = (v4u){o[0], o[1], o[2], o[3]}; *(LAS v4u*)((base) + wo1) = (v4u){o[4], o[5], o[6], o[7]}; } while (0)
      ST16S(slot + O_KKT, okk); ST16S(slot + O_RT, orr); ST16S(hs + H_BT, ob); ST16S(hs + H_KDT, okd); ST16S(slot + O_BGT, oyb); ST16S(slot + O_KGT, oyk);
#undef ST16S
      *(LAS v4u*)(slot + O_VT + wo0) = (v4u){rv[0].x, rv[0].y, rv[1].x, rv[1].y}; *(LAS v4u*)(slot + O_VT + wo1) = (v4u){rv[2].x, rv[2].y, rv[3].x, rv[3].y};
      *(LAS float*)(slot + O_GC + lane * 4) = gC; }
    LDS_WAIT(); asm volatile("" ::: "memory");
    f32x4 g1 = {0.f, 0.f, 0.f, 0.f}, g2 = g1, g3 = g1, g4 = g1, g1b = g1;
    { const int a0 = (8 * g + q) * 32 + ((p * 8) ^ ((g & 1) * 16)), a1 = (8 * g + 4 + q) * 32 + ((p * 8) ^ (((g & 1) ^ 1) * 16));
      v2u b00 = trr<H_BT>(hb + a0), b01 = trr<H_BT>(hb + a1), b10 = trr<H_BT + 1024>(hb + a0), b11 = trr<H_BT + 1024>(hb + a1);
      v2u d00 = trr<H_KDT>(hb + a0), d01 = trr<H_KDT>(hb + a1), d10 = trr<H_KDT + 1024>(hb + a0), d11 = trr<H_KDT + 1024>(hb + a1);
      v2u k00 = trr<O_KKT>(sb + a0), k01 = trr<O_KKT>(sb + a1), k10 = trr<O_KKT + 1024>(sb + a0), k11 = trr<O_KKT + 1024>(sb + a1);
      v2u r00 = trr<O_RT>(sb + a0), r01 = trr<O_RT>(sb + a1), r10 = trr<O_RT + 1024>(sb + a0), r11 = trr<O_RT + 1024>(sb + a1);
      TIE4(b00, b01, b10, b11); TIE4(d00, d01, d10, d11); TIE4(k00, k01, k10, k11); TIE4(r00, r01, r10, r11);
      { const bf16x8 aB = cat2(b00, b01), aD = cat2(d00, d01), bK = cat2(k00, k01), bR = cat2(r00, r01);
        g1 = mfma32(aB, bK, g1); g2 = mfma32(aD, bK, g2); g3 = mfma32(aB, bR, g3); g4 = mfma32(aD, bR, g4); g1b = mfma32(bK, aB, g1b); }
      { const bf16x8 aB = cat2(b10, b11), aD = cat2(d10, d11), bK = cat2(k10, k11), bR = cat2(r10, r11);
        g1 = mfma32(aB, bK, g1); g2 = mfma32(aD, bK, g2); g3 = mfma32(aB, bR, g3); g4 = mfma32(aD, bR, g4); g1b = mfma32(bK, aB, g1b); } }
#pragma unroll
    for (int r = 0; r < 4; ++r) { const int j = 4 * g + r; if (!(j < l15)) { g1[r] = 0.f; g2[r] = 0.f; } if (!(j <= l15)) { g3[r] = 0.f; g4[r] = 0.f; } if (!(l15 < j)) g1b[r] = 0.f; }
    const int po = l15 * 32 + ((g * 8) ^ sw16(l15));
    { v2u w; w.x = pk2(-g3[0], -g3[1]); w.y = pk2(-g3[2], -g3[3]); *(LAS v2u*)(slot + O_NBR + po) = w; }
    { const f32x4 z4 = {0.f, 0.f, 0.f, 0.f};
      f32x4 t1a, t1b;
#pragma unroll
      for (int r = 0; r < 4; ++r) { const float dg = (4 * g + r == l15) ? 1.f : 0.f; t1a[r] = dg - g1[r]; t1b[r] = dg - g1b[r]; }
      const s16x4 mA = pack4(g1), mB = pack4(g1b);
      const f32x4 s2b = mfma16(mA, mB, z4), s2a = mfma16(mB, mA, z4);
      const s16x4 s2A = pack4(s2a), s2B = pack4(s2b);
      const f32x4 s4b = mfma16(s2A, s2B, z4), s4a = mfma16(s2B, s2A, z4);
      const s16x4 s4A = pack4(s4a), s4B = pack4(s4b);
      const f32x4 s8b = mfma16(s4A, s4B, z4);
      const s16x4 t1A = pack4(t1a);
      const f32x4 t2b = mfma16(t1A, s2B, t1b), t2a = mfma16(s2B, t1A, t1a);
      const s16x4 t2A = pack4(t2a);
      const f32x4 t3b = mfma16(t2A, s4B, t2b), t3a = mfma16(s4B, t2A, t2a);
      (void)t3b;
      const f32x4 ta = mfma16(pack4(s8b), pack4(t3a), t3a);
      *(LAS s16x4*)(slot + O_TM + po) = pack4(ta); }
    *(LAS s16x4*)(slot + O_Z1 + po) = pack4(g2); *(LAS s16x4*)(slot + O_Z2 + po) = pack4(g4);
    LDS_WAIT(); asm volatile("" ::: "memory");
}
template <bool STORE = true>
__device__ __forceinline__ void main_chunk(f32x4 (&acc)[4], const LAS unsigned char* slot, int w, int lane, float* YD, int dir, int b, int h, int t0) {
    const int l15 = lane & 15, g = lane >> 4, q = (lane >> 2) & 3, p = lane & 3;
    const int sb = (int)(uintptr_t)slot;
    const int po = sb + l15 * 32 + ((g * 8) ^ sw16(l15));
    const int mb = sb + (4 * g + q) * 32 + ((p * 8) ^ sw16(4 * g + q));
    v2u k00 = trr<O_KKT>(mb), k01 = trr<O_KKT + 512>(mb), k10 = trr<O_KKT + 1024>(mb), k11 = trr<O_KKT + 1536>(mb);
    v2u r00 = trr<O_RT>(mb), r01 = trr<O_RT + 512>(mb), r10 = trr<O_RT + 1024>(mb), r11 = trr<O_RT + 1536>(mb);
    v2u vbr = rd64<0>(po + O_VT + 512 * w), z1 = rd64<O_Z1>(po), z2 = rd64<O_Z2>(po), tm = rd64<O_TM>(po), nbr = rd64<O_NBR>(po);
    v2u kg0 = rd64<O_KGT>(po), kg1 = rd64<O_KGT + 512>(po), kg2 = rd64<O_KGT + 1024>(po), kg3 = rd64<O_KGT + 1536>(po);
    v2u bg0 = rd64<O_BGT>(po), bg1 = rd64<O_BGT + 512>(po), bg2 = rd64<O_BGT + 1024>(po), bg3 = rd64<O_BGT + 1536>(po);
    bf16x8 sbk[2];
#pragma unroll
    for (int ks = 0; ks < 2; ++ks) { v4u c; c.x = pk2(acc[2 * ks][0], acc[2 * ks][1]); c.y = pk2(acc[2 * ks][2], acc[2 * ks][3]); c.z = pk2(acc[2 * ks + 1][0], acc[2 * ks + 1][1]); c.w = pk2(acc[2 * ks + 1][2], acc[2 * ks + 1][3]); sbk[ks] = __builtin_bit_cast(bf16x8, c); }
    f32x4 gc[4];
#pragma unroll
    for (int kt = 0; kt < 4; ++kt) gc[kt] = *(const LAS f32x4*)(slot + O_GC + (16 * kt + 4 * g) * 4);
    TIE4(k00, k01, k10, k11); TIE4(r00, r01, r10, r11); TIE4(vbr, z1, z2, tm); TIE4(nbr, kg0, kg1, kg2); TIE4(kg3, bg0, bg1, bg2); TIE1(bg3);
    const s16x4 vb = as4(vbr);
    f32x4 x1 = mfma16(as4(z1), vb, (f32x4){0.f, 0.f, 0.f, 0.f}), x2 = mfma16(as4(z2), vb, (f32x4){0.f, 0.f, 0.f, 0.f});
    x1 = mfma32(cat2(k00, k01), sbk[0], x1); x2 = mfma32(cat2(r00, r01), sbk[0], x2);
    x1 = mfma32(cat2(k10, k11), sbk[1], x1); x2 = mfma32(cat2(r10, r11), sbk[1], x2);
    const f32x4 u = mfma16(as4(tm), pack4(x1), (f32x4){0.f, 0.f, 0.f, 0.f});
    const s16x4 ub = pack4(u);
    const f32x4 y = mfma16(as4(nbr), ub, x2);
    if (STORE) {
#pragma unroll
    for (int r = 0; r < 4; ++r) YD[(size_t)scan_row(dir, b, t0 + 4 * g + r) * 1024 + h * 64 + 16 * w + l15] = y[r]; }
    else { asm volatile("" :: "v"(y)); }
    acc[0] = mfma16(as4(bg0), ub, mfma16(as4(kg0), vb, acc[0] * gc[0])); acc[1] = mfma16(as4(bg1), ub, mfma16(as4(kg1), vb, acc[1] * gc[1]));
    acc[2] = mfma16(as4(bg2), ub, mfma16(as4(kg2), vb, acc[2] * gc[2])); acc[3] = mfma16(as4(bg3), ub, mfma16(as4(kg3), vb, acc[3] * gc[3]));
}
__device__ __forceinline__ void scan_unit2(Frame& F, int u) {
    constexpr int T = CTX + SEQ, NG = T / (4 * C);
    const int dir = u & 1, b = u >> 5, h = (u >> 1) & 15;
    const bf16* const arr[6] = {FEAT(FE_E0 + 2 * dir), FEAT(FE_KK), FEAT(FE_A0 + 2 * dir), FEAT(FE_K), FEAT(FE_R), FEAT(FE_V)};
    const float kac = KIN(19)[h * 64 + F.lane];
    float* YD = (float*)(F.ws + WS_YD) + (size_t)dir * RT * 1024;
    const bool helper = F.wave >= 4; int hw = F.wave & 3; int lane = F.lane;
    __builtin_amdgcn_s_waitcnt(0x0F70);
    asm volatile("" : "+s"(hw), "+v"(lane));
    LAS unsigned char* hs = F.lds + HS_OFF + hw * HS_SZ;
    if (helper) {
#ifdef SCAN_HPRIO
        __builtin_amdgcn_s_setprio(2);
#endif
        v4u ld[12], ln[12];
        h_load(ld, arr, dir, b, h, hw * C, lane);
        helper_chunk(ld, F.lds + hw * SLOT, hs, lane, kac);
        if (NG > 1) h_load(ln, arr, dir, b, h, (4 + hw) * C, lane);
        __syncthreads();
#pragma unroll 1
        for (int G = 0; G < NG; ++G) {
            if (G + 1 < NG) {
#pragma unroll
                for (int i = 0; i < 12; ++i) ld[i] = ln[i];
                if (G + 2 < NG) h_load(ln, arr, dir, b, h, (4 * (G + 2) + hw) * C, lane);
#ifdef SCANP_H
#pragma unroll 1
                for (int rep = 0; rep < SCANP_H; ++rep)
#endif
                helper_chunk(ld, F.lds + (((G + 1) & 1) * 4 + hw) * SLOT, hs, lane, kac); }
            __syncthreads();
        }
#ifdef SCAN_HPRIO
        __builtin_amdgcn_s_setprio(0);
#endif
    } else {
        f32x4 acc[4];
#pragma unroll
        for (int kt = 0; kt < 4; ++kt) acc[kt] = (f32x4){0.f, 0.f, 0.f, 0.f};
#ifdef SCAN_CVPIPE
        constexpr int SH = TI_NQ / 8; const int shard = blockIdx.x & 7;
        LAS float* scr = (LAS float*)(F.lds + CV_OFF + hw * 8192);
        int cq = -1; f32x4 c0[8], c1[8];
#define CV_GRAB() do { unsigned q_ = 0; if (lane == 0) q_ = __hip_atomic_fetch_add(F.ctl + CW_CQ + 64 * shard, 2u, __ATOMIC_RELAXED, __HIP_MEMORY_SCOPE_AGENT); q_ = (unsigned)__builtin_amdgcn_readfirstlane((int)q_); \
            cq = -1; if (q_ < (unsigned)SH) { cq = shard * SH + (int)q_; const TrItem t0 = tr_decode(F, cq), t1 = tr_decode(F, cq + 1); tr_load(t0, c0, lane); tr_load(t1, c1, lane); } } while (0)
        CV_GRAB();
        __syncthreads();
#pragma unroll 1
        for (int G = 0; G < NG; ++G) {
#pragma unroll
            for (int c = 0; c < 4; ++c) main_chunk(acc, F.lds + ((G & 1) * 4 + c) * SLOT, hw, lane, YD, dir, b, h, (4 * G + c) * C);
            if (cq >= 0) { __builtin_amdgcn_s_waitcnt(0x4F70);
                const TrItem t0 = tr_decode(F, cq); tr_store(t0, c0, scr, lane); const TrItem t1 = tr_decode(F, cq + 1); tr_store(t1, c1, scr, lane); cq = -1; }
            if (G + 1 < NG) CV_GRAB();
            __syncthreads();
        }
#undef CV_GRAB
#else
        __syncthreads();
#pragma unroll 1
        for (int G = 0; G < NG; ++G) {
#pragma unroll 1
            for (int c = 0; c < 4; ++c) main_chunk(acc, F.lds + ((G & 1) * 4 + c) * SLOT, hw, lane, YD, dir, b, h, (4 * G + c) * C);
#ifdef SCANP_M
            { f32x4 acd[4];
#pragma unroll
              for (int kt = 0; kt < 4; ++kt) acd[kt] = acc[kt];
#pragma unroll 1
              for (int c = 0; c < 4; ++c) main_chunk<(SCANP_M > 1)>(acd, F.lds + ((G & 1) * 4 + c) * SLOT, hw, lane, (float*)(F.ws + WS_ACTB), dir, b, h, (4 * G + c) * C); }
#endif
#ifndef SCANP_NOCV
            if (G + 1 < NG) convert_grab(F, (LAS float*)(F.lds + CV_OFF + hw * 8192));
#endif
            __syncthreads();
        }
#endif
    }
}
}

constexpr size_t WS_ROPE = WS_CTL + 512 * 1024;
constexpr int LDQKV = 3 * D;
constexpr float QSCALE = 0.125f * 1.4426950408889634f;
__device__ __forceinline__ void p0_rope_table(Frame& F) {
    float* RT_ = WSP(float, WS_ROPE);
    const int gt = blockIdx.x * 512 + F.tid, NGT = F.G * 512;
    for (int i = gt; i < SEQ * 32; i += NGT) { const int t = i >> 5, j2 = i & 31, ax = j2 >> 4, j = j2 & 15;
        const float inv = powf(10000.0f, -(float)j / 16.0f), th = (float)(ax ? (t & 63) : (t >> 6)) * inv; RT_[2 * i] = cosf(th); RT_[2 * i + 1] = sinf(th); }
}
__device__ __forceinline__ float dpp_x1(float v) { return __builtin_bit_cast(float, __builtin_amdgcn_update_dpp(0, __builtin_bit_cast(int, v), 0xB1, 0xF, 0xF, true)); }
__device__ __forceinline__ float dpp_x2(float v) { return __builtin_bit_cast(float, __builtin_amdgcn_update_dpp(0, __builtin_bit_cast(int, v), 0x4E, 0xF, 0xF, true)); }
__device__ __forceinline__ float dpp_hm(float v) { return __builtin_bit_cast(float, __builtin_amdgcn_update_dpp(0, __builtin_bit_cast(int, v), 0x141, 0xF, 0xF, true)); }
template <bool LAT>
__device__ __forceinline__ void qknorm_rope_seg(Frame& F, bf16* QKV, int s0, int send, const float (&gq)[8], const float (&gk)[8]) {
    constexpr int J0 = LAT ? 0 : 4;
    const float* RT_ = WSP(float, WS_ROPE);
    const int t = F.lane & 7, co = 2 * ((t >> 2) * 16 + 8 * (t & 1));
    const float sgn = (t & 2) ? 1.0f : -1.0f;
#define QK_LOAD(B, C, r_) do { const v4u* p_ = (const v4u*)(QKV + (size_t)(r_) * LDQKV); _Pragma("unroll") for (int j = J0; j < 8; ++j) B[j] = p_[F.lane + 64 * j];                     \
        if (LAT) { const f32x4* c_ = (const f32x4*)(RT_ + (size_t)((r_) & (SEQ - 1)) * 64 + co); _Pragma("unroll") for (int q = 0; q < 4; ++q) C[q] = c_[q]; }                              \
        asm volatile("" ::: "memory"); __builtin_amdgcn_sched_barrier(0); } while (0)
#define QK_ROW(B, C, r_) do { v4u* p_ = (v4u*)(QKV + (size_t)(r_) * LDQKV);                                                                                                          \
        _Pragma("unroll") for (int j = J0; j < 8; ++j) { float x[8]; unpack8(B[j], x); float ss = 0.f;                                                                                   \
            _Pragma("unroll") for (int e = 0; e < 8; ++e) ss += x[e] * x[e];                                                                                                            \
            ss += dpp_x1(ss); ss += dpp_x2(ss); ss += dpp_hm(ss);                                                                                                                      \
            const float rstd = 1.0f / sqrtf(ss * (1.0f / 64.0f) + 1e-6f);                                                                                                               \
            _Pragma("unroll") for (int e = 0; e < 8; ++e) x[e] = x[e] * rstd * (j < 4 ? gq[e] : gk[e]);                                                                                  \
            if (LAT) { _Pragma("unroll") for (int e = 0; e < 8; ++e) { const float c = C[e >> 1][(e & 1) * 2], s = C[e >> 1][(e & 1) * 2 + 1]; const float o_ = dpp_x2(x[e]); x[e] = x[e] * c + o_ * (sgn * s); } } \
            p_[F.lane + 64 * j] = pack8(x); }                                                                                                                                          \
        asm volatile("" ::: "memory"); __builtin_amdgcn_sched_barrier(0); } while (0)
    v4u A[8], B[8]; f32x4 CA[4], CB[4];
    QK_LOAD(A, CA, s0);
    __builtin_amdgcn_s_waitcnt(0x0F70);
#pragma unroll 1
    for (int r = s0; r < send; r += 2) {
        __builtin_amdgcn_s_waitcnt(LAT ? 0x0F78 : 0x0F74);
        if (r + 1 < send) QK_LOAD(B, CB, r + 1);
        QK_ROW(A, CA, r);
        if (r + 1 < send) { __builtin_amdgcn_s_waitcnt(LAT ? 0x0F78 : 0x0F74); if (r + 2 < send) QK_LOAD(A, CA, r + 2); QK_ROW(B, CB, r + 1); }
    }
    __builtin_amdgcn_s_waitcnt(0x0F70);
#undef QK_LOAD
#undef QK_ROW
}
__device__ __forceinline__ void qknorm_rope_rows(Frame& F, bf16* QKV) {
    const int gw = __builtin_amdgcn_readfirstlane(blockIdx.x * NWAVES + F.wave), NGW = F.G * NWAVES;
    const int per = (RT + NGW - 1) / NGW, r0 = gw * per, r1 = min(RT, r0 + per);
    if (r0 >= r1) return;
    const int t = F.lane & 7; float gq[8], gk[8];
#pragma unroll
    for (int e = 0; e < 8; ++e) { gq[e] = KIN(32)[8 * t + e] * QSCALE; gk[e] = KIN(33)[8 * t + e]; }
    __builtin_amdgcn_s_waitcnt(0x0F70);
    if (r0 < RL) qknorm_rope_seg<true>(F, QKV, r0, min(r1, RL), gq, gk);
    if (r1 > RL) qknorm_rope_seg<false>(F, QKV, max(r0, RL), r1, gq, gk);
}

namespace att {
constexpr int KVBLK = 64, NT = (CTX + SEQ) / KVBLK;
constexpr int SHM_V = KVBLK * 128 * 2, SHM_K = KVBLK * 64 * 2;
#define KSWZ64(row, colB) ((row) * 128 + ((colB) ^ ((((row) >> 1) & 7) << 4)))
#define SBAR() __builtin_amdgcn_sched_barrier(0)
__device__ __forceinline__ int crow(int r, int hi) { return (r & 3) + 8 * (r >> 2) + 4 * hi; }
__device__ __forceinline__ unsigned cvtpk(float lo, float hi) { unsigned r; asm volatile("v_cvt_pk_bf16_f32 %0, %1, %2" : "=v"(r) : "v"(lo), "v"(hi)); return r; }
__device__ __forceinline__ int v_st(int k, int c) { const int kk = (k & ~0xC) | ((k & 4) << 1) | ((k & 8) >> 1); return ((kk >> 3) * 4 + (c >> 5)) * 512 + ((kk & 7) * 32 + (c & 31)) * 2; }
__device__ __forceinline__ int v_rd_base(int lane) { return ((lane & 3) << 3) | (((lane >> 2) & 3) << 6) | (((lane >> 4) & 1) << 5) | (((lane >> 5) & 1) << 8); }
constexpr int v_rd_off(int d0, int ks, int half) { return d0 * 512 + ks * 4096 + half * 2048; }
template <int OFF> __device__ __forceinline__ s16x4 tr_read(int vb) { s16x4 r; asm volatile("ds_read_b64_tr_b16 %0, %1 offset:%2" : "=&v"(r) : "v"(vb), "i"(OFF) : "memory"); return r; }
template <int D0, bool PRIO = false> __device__ __forceinline__ void pv_one(f32x16& od, int vb, bf16x8 pa0, bf16x8 pa1, bf16x8 pa2, bf16x8 pa3) {
    const s16x4 l0 = tr_read<v_rd_off(D0, 0, 0)>(vb), h0 = tr_read<v_rd_off(D0, 0, 1)>(vb), l1 = tr_read<v_rd_off(D0, 1, 0)>(vb), h1 = tr_read<v_rd_off(D0, 1, 1)>(vb);
    const s16x4 l2 = tr_read<v_rd_off(D0, 2, 0)>(vb), h2 = tr_read<v_rd_off(D0, 2, 1)>(vb), l3 = tr_read<v_rd_off(D0, 3, 0)>(vb), h3 = tr_read<v_rd_off(D0, 3, 1)>(vb);
    asm volatile("s_waitcnt lgkmcnt(0)" ::: "memory"); SBAR();
#define PK(L, H) (bf16x8){L[0], L[1], L[2], L[3], H[0], H[1], H[2], H[3]}
#ifdef ATT_SETPRIO
    if (PRIO) __builtin_amdgcn_s_setprio(1);
#endif
    od = __builtin_amdgcn_mfma_f32_32x32x16_bf16(pa0, PK(l0, h0), od, 0, 0, 0);
    od = __builtin_amdgcn_mfma_f32_32x32x16_bf16(pa1, PK(l1, h1), od, 0, 0, 0);
    od = __builtin_amdgcn_mfma_f32_32x32x16_bf16(pa2, PK(l2, h2), od, 0, 0, 0);
    od = __builtin_amdgcn_mfma_f32_32x32x16_bf16(pa3, PK(l3, h3), od, 0, 0, 0);
#ifdef ATT_SETPRIO
    if (PRIO) __builtin_amdgcn_s_setprio(0);
#endif
#undef PK
}
__device__ __forceinline__ size_t key_row(int b, int j) { return j < CTX ? (size_t)(RL + b * CTX + j) : (size_t)(b * SEQ + j - CTX); }

template <bool ZI>
__device__ __forceinline__ void qkt64(f32x16& p0, f32x16& p1, const LAS char* Ks, const bf16x8* qr, int r32, int hi, float negM) {
    float ini = 0.f;
    if (!ZI) { ini = negM; asm volatile("" : "+v"(ini)); }
#pragma unroll
    for (int r = 0; r < 16; ++r) { p0[r] = ini; p1[r] = ini; }
#pragma unroll
    for (int d0 = 0; d0 < 4; ++d0) { const int cb = (d0 * 16 + hi * 8) * 2;
        const bf16x8 b0 = *(const LAS bf16x8*)(Ks + KSWZ64(r32, cb)), b1 = *(const LAS bf16x8*)(Ks + KSWZ64(32 + r32, cb));
        p0 = __builtin_amdgcn_mfma_f32_32x32x16_bf16(b0, qr[d0], p0, 0, 0, 0);
        p1 = __builtin_amdgcn_mfma_f32_32x32x16_bf16(b1, qr[d0], p1, 0, 0, 0); }
}
__device__ __forceinline__ void partialSM(f32x16& p0) {
#pragma unroll
    for (int r = 0; r < 16; ++r) p0[r] = __builtin_amdgcn_exp2f(p0[r]);
}
__device__ __forceinline__ void finishSM(f32x16& p0, f32x16& p1, float& l_reg, bf16x8& pa0, bf16x8& pa1, bf16x8& pa2, bf16x8& pa3) {
#pragma unroll
    for (int r = 0; r < 16; ++r) p1[r] = __builtin_amdgcn_exp2f(p1[r]);
    float ps = 0.f;
#pragma unroll
    for (int r = 0; r < 16; ++r) ps += p0[r];
#pragma unroll
    for (int r = 0; r < 16; ++r) ps += p1[r];
    { auto rr = __builtin_amdgcn_permlane32_swap(__float_as_uint(ps), __float_as_uint(ps), false, false); ps = __uint_as_float(rr[0]) + __uint_as_float(rr[1]); }
    l_reg += ps;
#define PK4(P, BASE, OUT) do { unsigned a0 = cvtpk(P[BASE + 0], P[BASE + 1]), a1 = cvtpk(P[BASE + 2], P[BASE + 3]);   \
    unsigned b0_ = cvtpk(P[BASE + 4], P[BASE + 5]), b1_ = cvtpk(P[BASE + 6], P[BASE + 7]);                              \
    auto r0 = __builtin_amdgcn_permlane32_swap(a0, b0_, false, false); auto r1 = __builtin_amdgcn_permlane32_swap(a1, b1_, false, false); \
    v4u w_ = {r0[0], r1[0], r0[1], r1[1]}; OUT = __builtin_bit_cast(bf16x8, w_); } while (0)
    PK4(p0, 0, pa0); PK4(p0, 8, pa1); PK4(p1, 0, pa2); PK4(p1, 8, pa3);
#undef PK4
}
#ifdef ATT_PVPIPE
#define PV_RD(X, D0) do { X##0 = tr_read<v_rd_off(D0, 0, 0)>(vb); X##1 = tr_read<v_rd_off(D0, 0, 1)>(vb); X##2 = tr_read<v_rd_off(D0, 1, 0)>(vb); X##3 = tr_read<v_rd_off(D0, 1, 1)>(vb); \
        X##4 = tr_read<v_rd_off(D0, 2, 0)>(vb); X##5 = tr_read<v_rd_off(D0, 2, 1)>(vb); X##6 = tr_read<v_rd_off(D0, 3, 0)>(vb); X##7 = tr_read<v_rd_off(D0, 3, 1)>(vb); } while (0)
#define PV_WAIT(N, X) asm volatile("s_waitcnt lgkmcnt(" #N ")" : "+v"(X##0), "+v"(X##1), "+v"(X##2), "+v"(X##3), "+v"(X##4), "+v"(X##5), "+v"(X##6), "+v"(X##7) :: "memory")
#define PV_PK(L, H) (bf16x8){L[0], L[1], L[2], L[3], H[0], H[1], H[2], H[3]}
#define PV_MM(od, X) do { od = __builtin_amdgcn_mfma_f32_32x32x16_bf16(pa0, PV_PK(X##0, X##1), od, 0, 0, 0); od = __builtin_amdgcn_mfma_f32_32x32x16_bf16(pa1, PV_PK(X##2, X##3), od, 0, 0, 0); \
        od = __builtin_amdgcn_mfma_f32_32x32x16_bf16(pa2, PV_PK(X##4, X##5), od, 0, 0, 0); od = __builtin_amdgcn_mfma_f32_32x32x16_bf16(pa3, PV_PK(X##6, X##7), od, 0, 0, 0); } while (0)
__device__ __forceinline__ void pv_all(f32x16* o, int vb, bf16x8 pa0, bf16x8 pa1, bf16x8 pa2, bf16x8 pa3) {
    s16x4 A0, A1, A2, A3, A4, A5, A6, A7, B0, B1, B2, B3, B4, B5, B6, B7;
    PV_RD(A, 0); PV_RD(B, 1);
    PV_WAIT(8, A); SBAR(); PV_MM(o[0], A); SBAR();
    PV_RD(A, 2);
    PV_WAIT(8, B); SBAR(); PV_MM(o[1], B); SBAR();
    PV_RD(B, 3);
    PV_WAIT(8, A); SBAR(); PV_MM(o[2], A); SBAR();
    PV_WAIT(0, B); SBAR(); PV_MM(o[3], B);
}
#undef PV_RD
#undef PV_WAIT
#undef PV_PK
#undef PV_MM
#else
template <bool PRIO = false>
__device__ __forceinline__ void pv_all(f32x16* o, int vb, bf16x8 pa0, bf16x8 pa1, bf16x8 pa2, bf16x8 pa3) {
    pv_one<0, PRIO>(o[0], vb, pa0, pa1, pa2, pa3); pv_one<1, PRIO>(o[1], vb, pa0, pa1, pa2, pa3); pv_one<2, PRIO>(o[2], vb, pa0, pa1, pa2, pa3); pv_one<3, PRIO>(o[3], vb, pa0, pa1, pa2, pa3);
}
#endif
template <bool ZI>
__device__ __forceinline__ void attn_unit(Frame& F, int u, const bf16* QKV, bf16* AO, float negM, float lam, float rsc) {
    const int x8 = u & 7, w = u >> 3, qt = w & 7, combo = (w >> 3) * 8 + x8;
    const int h = combo & 15, b = combo >> 4;
    asm volatile("" : "+s"(QKV), "+s"(AO));
    int lane; asm volatile("v_mbcnt_lo_u32_b32 %0, -1, 0\n\tv_mbcnt_hi_u32_b32 %0, -1, %0" : "=v"(lane));
    const int wid = F.wave, tid = wid * 64 + lane, r32 = lane & 31, hi = lane >> 5;
    LAS char* lds = (LAS char*)F.lds;
    LAS char* V_lds = lds; LAS char* K_lds = lds + 2 * SHM_V; LAS float* li_l = (LAS float*)(lds + 2 * SHM_V + 2 * SHM_K) + wid * 64;
    LAS char* park = lds + 2 * SHM_V + 2 * SHM_K + 2048 + wid * 8192;
    const bf16* Vc = QKV + 2 * D + h * 128;
    const int ksr = tid >> 3, ksc = (tid & 7) * 8;
    const int vsr = tid >> 4, vsc = (tid & 15) * 8, vst0 = v_st(vsr, vsc), vst1 = v_st(32 + vsr, vsc);
    const int vb0 = (int)(uintptr_t)V_lds + v_rd_base(lane);
    struct { v4u k, v0, v1; } sr_[1];
#define SLOAD(i, j0) do { sr_[i].k = *(const v4u*)(Kc + key_row(b, (j0) + ksr) * LDQKV + ksc); sr_[i].v0 = *(const v4u*)(Vc + key_row(b, (j0) + vsr) * LDQKV + vsc); sr_[i].v1 = *(const v4u*)(Vc + key_row(b, (j0) + 32 + vsr) * LDQKV + vsc); } while (0)
#define SWRITE(bi, i) do { *(LAS v4u*)(K_lds + (bi) * SHM_K + KSWZ64(ksr, ksc * 2)) = sr_[i].k; *(LAS v4u*)(V_lds + (bi) * SHM_V + vst0) = sr_[i].v0; *(LAS v4u*)(V_lds + (bi) * SHM_V + vst1) = sr_[i].v1; } while (0)
#define SWAIT() asm volatile("s_waitcnt vmcnt(0)" ::: "memory")
#pragma unroll 1
    for (int sub = 0; sub < 2; ++sub) {
    const bf16* Qw = QKV + (size_t)(b * SEQ + qt * 256 + wid * 32 + r32) * LDQKV + h * 128 + sub * 64 + hi * 8;
    bf16x8 qr[4];
#pragma unroll
    for (int d0 = 0; d0 < 4; ++d0) qr[d0] = *(const bf16x8*)(Qw + d0 * 16);
    const bf16* Kc = QKV + D + h * 128 + sub * 64;
    f32x16 o[4] = {}; float l_reg = 0.f;
    f32x16 pA0, pA1, pB0, pB1; bf16x8 pa0, pa1, pa2, pa3;
    SLOAD(0, 0); asm volatile("s_waitcnt vmcnt(0)" ::: "memory"); SWRITE(0, 0); __syncthreads();
    qkt64<ZI>(pA0, pA1, K_lds, qr, r32, hi, negM); partialSM(pA0);
    SLOAD(0, KVBLK);
    SWAIT(); SWRITE(1, 0); __syncthreads();
#pragma unroll 1
    for (int j = 1; j + 1 < NT; j += 2) {
        SBAR(); qkt64<ZI>(pB0, pB1, K_lds + SHM_K, qr, r32, hi, negM);
        finishSM(pA0, pA1, l_reg, pa0, pa1, pa2, pa3); SBAR();
        SLOAD(0, (j + 1) * KVBLK); SBAR();
        pv_all<ZI>(o, vb0, pa0, pa1, pa2, pa3); partialSM(pB0);
        __syncthreads(); SWAIT(); SWRITE(0, 0);
        __syncthreads();
        SBAR(); qkt64<ZI>(pA0, pA1, K_lds, qr, r32, hi, negM);
        finishSM(pB0, pB1, l_reg, pa0, pa1, pa2, pa3); SBAR();
        SLOAD(0, (j + 2) * KVBLK); SBAR();
        pv_all<ZI>(o, vb0 + SHM_V, pa0, pa1, pa2, pa3); partialSM(pA0);
        __syncthreads(); SWAIT(); SWRITE(1, 0);
        __syncthreads();
    }
    SBAR(); qkt64<ZI>(pB0, pB1, K_lds + SHM_K, qr, r32, hi, negM);
    finishSM(pA0, pA1, l_reg, pa0, pa1, pa2, pa3); SBAR();
    pv_all<ZI>(o, vb0, pa0, pa1, pa2, pa3); partialSM(pB0);
    finishSM(pB0, pB1, l_reg, pa0, pa1, pa2, pa3); SBAR();
    pv_all<ZI>(o, vb0 + SHM_V, pa0, pa1, pa2, pa3);
    if (hi == 0) li_l[r32] = l_reg;
    asm volatile("s_waitcnt lgkmcnt(0)" ::: "memory");
    if (sub == 0) {
#pragma unroll
        for (int gi = 0; gi < 8; ++gi) { unsigned wv[4];
#pragma unroll
            for (int c = 0; c < 4; ++c) { const int dw = gi * 4 + c, d0 = dw >> 3, i = dw & 7;
                const float rl0 = __builtin_amdgcn_rcpf(li_l[crow(2 * i, hi)]), rl1 = __builtin_amdgcn_rcpf(li_l[crow(2 * i + 1, hi)]);
                wv[c] = pk2(o[d0][2 * i] * rl0, o[d0][2 * i + 1] * rl1); }
            *(LAS v4u*)(park + gi * 1024 + lane * 16) = (v4u){wv[0], wv[1], wv[2], wv[3]}; }
    } else {
        float ss[16];
#pragma unroll
        for (int r = 0; r < 16; ++r) ss[r] = 0.f;
#pragma unroll
        for (int gi = 0; gi < 8; ++gi) { const v4u pk = *(const LAS v4u*)(park + gi * 1024 + lane * 16); const unsigned wv[4] = {pk.x, pk.y, pk.z, pk.w};
#pragma unroll
            for (int c = 0; c < 4; ++c) { const int dw = gi * 4 + c, d0 = dw >> 3, i = dw & 7;
                const float rl0 = __builtin_amdgcn_rcpf(li_l[crow(2 * i, hi)]), rl1 = __builtin_amdgcn_rcpf(li_l[crow(2 * i + 1, hi)]);
                const float v0 = bflo(wv[c]) - lam * (o[d0][2 * i] * rl0), v1 = bfhi(wv[c]) - lam * (o[d0][2 * i + 1] * rl1);
                o[d0][2 * i] = v0; o[d0][2 * i + 1] = v1; ss[2 * i] += v0 * v0; ss[2 * i + 1] += v1 * v1; } }
#pragma unroll
        for (int m = 1; m < 32; m <<= 1)
#pragma unroll
            for (int r = 0; r < 16; ++r) ss[r] += __shfl_xor(ss[r], m);
        float g4[4];
#pragma unroll
        for (int d0 = 0; d0 < 4; ++d0) { int r32e = r32; asm volatile("" : "+v"(r32e)); g4[d0] = KIN(38)[d0 * 32 + r32e]; }
        asm volatile("s_waitcnt lgkmcnt(0)" ::: "memory");
#ifdef WO1_F8
#pragma unroll
        for (int r = 0; r < 16; ++r) { const float rstd = SC_A8 * rsc / sqrtf(ss[r] * (1.0f / 128.0f) + 1e-5f); const int orow = crow(r, hi);
            const unsigned w4 = pk4_fp8(o[0][r] * rstd * g4[0], o[1][r] * rstd * g4[1], o[2][r] * rstd * g4[2], o[3][r] * rstd * g4[3]);
#pragma unroll
            for (int d0 = 0; d0 < 4; ++d0) *(LAS unsigned char*)(park + orow * 128 + d0 * 32 + r32) = (unsigned char)(w4 >> (8 * d0)); }
        asm volatile("s_waitcnt lgkmcnt(0)" ::: "memory");
        unsigned char* Ow = (unsigned char*)AO + (size_t)(b * SEQ + qt * 256 + wid * 32) * D + h * 128;
#pragma unroll
        for (int i = 0; i < 4; ++i) { const int row = 8 * i + (lane >> 3), ch = lane & 7;
            *(v4u*)(Ow + (size_t)row * D + ch * 16) = *(const LAS v4u*)(park + row * 128 + ch * 16); }
#else
#pragma unroll
        for (int r = 0; r < 16; ++r) { const float rstd = rsc / sqrtf(ss[r] * (1.0f / 128.0f) + 1e-5f); const int orow = crow(r, hi);
#pragma unroll
            for (int d0 = 0; d0 < 4; ++d0) *(LAS unsigned short*)(park + orow * 256 + (d0 * 32 + r32) * 2) = f2bf(o[d0][r] * rstd * g4[d0]); }
        asm volatile("s_waitcnt lgkmcnt(0)" ::: "memory");
        bf16* Ow = AO + (size_t)(b * SEQ + qt * 256 + wid * 32) * D + h * 128;
#pragma unroll
        for (int i = 0; i < 8; ++i) { const int row = 4 * i + (lane >> 4), ch = lane & 15;
            *(v4u*)(Ow + (size_t)row * D + ch * 8) = *(const LAS v4u*)(park + row * 256 + ch * 16); }
#endif
    }
    __syncthreads();
    }
#undef SLOAD
#undef SWRITE
#undef SWAIT
}
#undef SBAR
}

__device__ __forceinline__ void attn_combine_rows(Frame& F, const bf16* OT, bf16* AO) {
    const int gw = blockIdx.x * NWAVES + F.wave, NGW = F.G * NWAVES;
    const float s1 = wave_sum(KIN(34)[F.lane] * KIN(35)[F.lane]), s2 = wave_sum(KIN(36)[F.lane] * KIN(37)[F.lane]);
    const float lam_init = 0.8f - 0.6f * expf(-0.3f), lam = expf(s1) - expf(s2) + lam_init;
    const int hd = F.lane >> 2, e0 = (F.lane & 3) * 32;
    for (int r = gw; r < RL; r += NGW) {
        const bf16* p1 = OT + (size_t)r * (2 * D) + (hd * 2) * 128 + e0; const bf16* p2 = p1 + 128;
        float o[32]; float ss = 0.f;
#pragma unroll
        for (int k = 0; k < 4; ++k) { float a[8], b[8]; unpack8(*(const v4u*)(p1 + 8 * k), a); unpack8(*(const v4u*)(p2 + 8 * k), b);
#pragma unroll
            for (int e = 0; e < 8; ++e) { const float v = a[e] - lam * b[e]; o[8 * k + e] = v; ss += v * v; } }
        ss += __shfl_xor(ss, 1); ss += __shfl_xor(ss, 2);
        const float rstd = (1.0f - lam_init) / sqrtf(ss * (1.0f / 128.0f) + 1e-5f);
#pragma unroll
        for (int k = 0; k < 4; ++k) { float f[8];
#pragma unroll
            for (int e = 0; e < 8; ++e) f[e] = o[8 * k + e] * rstd * KIN(38)[e0 + 8 * k + e];
            *(v4u*)(AO + (size_t)r * D + hd * 128 + e0 + 8 * k) = pack8(f); }
    }
}

constexpr int LDS_MOE_OFF = 132 * 1024;
__device__ __forceinline__ void moe_route_rows(Frame& F, const float* x, const float* g, const float* modl, unsigned char* A4) {
    LAS float* rt = (LAS float*)F.lds;
    LAS int* sel = (LAS int*)(F.lds + 64 * 1024);
    for (int i = F.tid; i < 2048 * 8; i += 512) { const int k = i >> 3, e = i & 7; rt[e * 2048 + k] = KIN(40)[i]; }
    __syncthreads();
    int* TOPI = (int*)(F.ws + WS_ROUTE + RO_TOPI); float* TOPG = (float*)(F.ws + WS_ROUTE + RO_TOPG); int* LRANK = (int*)(F.ws + WS_ROUTE + RO_LRANK); int* CNT = (int*)(F.ws + WS_ROUTE + RO_CNT);
    for (int ub = blockIdx.x; ub < RL / 64; ub += F.G) {
        const int rb = ub * 64 + 8 * F.wave, mrow = rb >> 11;
        LAS float* gml = (LAS float*)(F.lds + 72 * 1024); LAS float* hml = (LAS float*)(F.lds + 80 * 1024);
        { const f32x4* sh = (const f32x4*)(modl + (size_t)mrow * 12288 + 3 * 2048); const f32x4* sc = (const f32x4*)(modl + (size_t)mrow * 12288 + 4 * 2048);
          *(LAS f32x4*)(gml + 4 * F.tid) = ((const f32x4*)g)[F.tid] * (sc[F.tid] + 1.0f); *(LAS f32x4*)(hml + 4 * F.tid) = sh[F.tid]; }
        __syncthreads();
#define MR_LOAD(v, r_) do { const f32x4* s_ = (const f32x4*)(x + (size_t)(r_) * D); _Pragma("unroll") for (int q = 0; q < 8; ++q) v[q] = s_[F.lane + 64 * q]; asm volatile("" ::: "memory"); __builtin_amdgcn_sched_barrier(0); } while (0)
#define MR_ROW(v, r_) do { const int r = (r_), lr = r - ub * 64; float ss = 0.f;                                                                              \
            _Pragma("unroll") for (int q = 0; q < 8; ++q) ss += (v[q].x * v[q].x + v[q].y * v[q].y) + (v[q].z * v[q].z + v[q].w * v[q].w);                       \
            const float rstd = 1.0f / sqrtf(wave_sum(ss) * (1.0f / D) + 1e-6f);                                                                                 \
            float lg[8];                                                                                                                                       \
            _Pragma("unroll") for (int e = 0; e < 8; ++e) lg[e] = 0.f;                                                                                          \
            unsigned* o8 = (unsigned*)(A4 + (size_t)r * D);                                                                                                     \
            _Pragma("unroll") for (int q = 0; q < 8; ++q) { const int c4 = F.lane + 64 * q;                                                                     \
                const f32x4 y = v[q] * rstd * *(const LAS f32x4*)(gml + 4 * c4) + *(const LAS f32x4*)(hml + 4 * c4); o8[c4] = pk4_fp8(y.x * SC_A8, y.y * SC_A8, y.z * SC_A8, y.w * SC_A8);                              \
                _Pragma("unroll") for (int e = 0; e < 8; ++e) { const f32x4 rv = *(const LAS f32x4*)(rt + e * 2048 + 4 * c4); lg[e] += (y.x * rv.x + y.y * rv.y) + (y.z * rv.z + y.w * rv.w); } } \
            _Pragma("unroll") for (int e = 0; e < 8; ++e) lg[e] = wave_sum(lg[e]);                                                                              \
            int i1 = 0; float l1 = lg[0];                                                                                                                      \
            _Pragma("unroll") for (int e = 1; e < 8; ++e) if (lg[e] > l1) { l1 = lg[e]; i1 = e; }                                                               \
            int i2 = -1; float l2 = -3.0e38f;                                                                                                                  \
            _Pragma("unroll") for (int e = 0; e < 8; ++e) if (e != i1 && lg[e] > l2) { l2 = lg[e]; i2 = e; }                                                    \
            if (F.lane == 0) { const float g2 = 1.0f / (1.0f + expf(l1 - l2)); TOPI[2 * r] = i1; TOPI[2 * r + 1] = i2; TOPG[2 * r] = 1.0f - g2; TOPG[2 * r + 1] = g2; sel[2 * lr] = i1; sel[2 * lr + 1] = i2; } \
            asm volatile("" ::: "memory"); __builtin_amdgcn_sched_barrier(0); } while (0)
        f32x4 va[8], vb[8];
        MR_LOAD(va, rb);
        __builtin_amdgcn_s_waitcnt(0x0F70);
#pragma unroll 1
        for (int j = 0; j < 8; j += 2) {
            __builtin_amdgcn_s_waitcnt(0x0F78);
            MR_LOAD(vb, rb + j + 1);
            MR_ROW(va, rb + j);
            __builtin_amdgcn_s_waitcnt(0x0F78);
            if (j + 2 < 8) MR_LOAD(va, rb + j + 2);
            MR_ROW(vb, rb + j + 1);
        }
#undef MR_LOAD
#undef MR_ROW
        __syncthreads();
        if (F.wave == 0) {
            const int s0 = sel[2 * F.lane], s1 = sel[2 * F.lane + 1]; const unsigned long long lt = (1ull << F.lane) - 1ull; int rk0 = 0, rk1 = 0;
#pragma unroll
            for (int e = 0; e < 8; ++e) { const unsigned long long m0 = __ballot(s0 == e), m1 = __ballot(s1 == e); const int before = __popcll(m0 & lt) + __popcll(m1 & lt);
                if (s0 == e) rk0 = before; if (s1 == e) rk1 = before;
                if (F.lane == 0) CNT[ub * 8 + e] = __popcll(m0) + __popcll(m1); }
            LRANK[2 * (ub * 64 + F.lane)] = rk0; LRANK[2 * (ub * 64 + F.lane) + 1] = rk1;
        }
        __syncthreads();
    }
}
__device__ __forceinline__ int wave_sum_i(int v) {
#pragma unroll
    for (int m = 1; m < 64; m <<= 1) v += __shfl_xor(v, m);
    return v;
}
__device__ __forceinline__ void moe_layout(Frame& F, int ub) {
    LAS int* L = (LAS int*)(F.lds + LDS_MOE_OFF);
    LAS int* part = L + 512;
    const int* CNT = (const int*)(F.ws + WS_ROUTE + RO_CNT);
    if (F.wave < RL / 64 / 64) {
        int tv[8], pv[8];
#pragma unroll
        for (int e = 0; e < 8; ++e) { const int c = CNT[F.tid * 8 + e]; tv[e] = c; pv[e] = F.tid < ub ? c : 0; }
#pragma unroll
        for (int e = 0; e < 8; ++e) { tv[e] = wave_sum_i(tv[e]); pv[e] = wave_sum_i(pv[e]); }
        if (F.lane == 0) {
#pragma unroll
            for (int e = 0; e < 8; ++e) { part[F.wave * 16 + e] = tv[e]; part[F.wave * 16 + 8 + e] = pv[e]; } }
    }
    __syncthreads();
    if (F.tid < 16) { int sacc = 0;
#pragma unroll
        for (int w = 0; w < RL / 64 / 64; ++w) sacc += part[w * 16 + F.tid];
        L[F.tid < 8 ? F.tid : 24 + (F.tid - 8)] = sacc; }
    __syncthreads();
    if (F.tid == 0) { int row = 0, np = 0;
        for (int e = 0; e < 8; ++e) { L[8 + e] = row; const int pe = (L[e] + 255) >> 8; for (int p = 0; p < pe; ++p) L[32 + np + p] = e; np += pe; row += pe * 256; }
        L[16] = np; }
    __syncthreads();
}
__device__ __forceinline__ void moe_gather(Frame& F, const unsigned char* A4, unsigned char* AG) {
    LAS int* L = (LAS int*)(F.lds + LDS_MOE_OFF);
    const int* TOPI = (const int*)(F.ws + WS_ROUTE + RO_TOPI); const int* LRANK = (const int*)(F.ws + WS_ROUTE + RO_LRANK); int* ROWOF = (int*)(F.ws + WS_ROUTE + RO_ROWOF);
    for (int ub = blockIdx.x; ub < RL / 64; ub += F.G) {
        moe_layout(F, ub);
        {
            const int rbase = ub * 64 + 8 * F.wave; int dest = 0;
            if (F.lane < 16) { const int e = TOPI[2 * rbase + F.lane]; dest = L[8 + e] + L[24 + e] + LRANK[2 * rbase + F.lane]; ROWOF[2 * rbase + F.lane] = dest; }
            v4u v[8][2];
#pragma unroll
            for (int k = 0; k < 8; ++k) { const v4u* sp = (const v4u*)(A4 + (size_t)(rbase + k) * D); v[k][0] = sp[F.lane]; v[k][1] = sp[F.lane + 64]; }
#pragma unroll
            for (int k = 0; k < 8; ++k) { const int d1 = __builtin_amdgcn_readlane(dest, 2 * k), d2 = __builtin_amdgcn_readlane(dest, 2 * k + 1);
                v4u* p1 = (v4u*)(AG + (size_t)d1 * D); v4u* p2 = (v4u*)(AG + (size_t)d2 * D);
                p1[F.lane] = v[k][0]; p1[F.lane + 64] = v[k][1]; p2[F.lane] = v[k][0]; p2[F.lane + 64] = v[k][1]; }
        }
        __syncthreads();
    }
    if (blockIdx.x < 8) {
        moe_layout(F, -1);
        const int e = blockIdx.x, n = L[e], r0 = L[8 + e] + n, r1 = L[8 + e] + ((n + 255) >> 8) * 256;
        for (int r = r0 + F.wave; r < r1; r += NWAVES) { v4u* dp = (v4u*)(AG + (size_t)r * D);
#pragma unroll
            for (int q = 0; q < 2; ++q) dp[F.lane + 64 * q] = (v4u){0u, 0u, 0u, 0u}; }
    }
}
__device__ __forceinline__ void moe_combine_rows(Frame& F, float* x, const float* modl, const bf16* Y) {
    const int gw = __builtin_amdgcn_readfirstlane(blockIdx.x * NWAVES + F.wave), NGW = F.G * NWAVES;
    const float* TOPG = (const float*)(F.ws + WS_ROUTE + RO_TOPG); const int* ROWOF = (const int*)(F.ws + WS_ROUTE + RO_ROWOF);
    const int per = (RL + NGW - 1) / NGW, r0 = gw * per, r1 = min(RL, r0 + per);
#define MC_LOAD(Y1, Y2, X, r_) do { const int li = 2 * ((r_) - c0); const int d1 = __builtin_amdgcn_readlane(rov, li), d2 = __builtin_amdgcn_readlane(rov, li + 1);           \
        const v4u* p1 = (const v4u*)(Y + (size_t)d1 * D); const v4u* p2 = (const v4u*)(Y + (size_t)d2 * D); const f32x4* xp = (const f32x4*)(x + (size_t)(r_) * D);           \
        _Pragma("unroll") for (int q = 0; q < 4; ++q) { const int c8 = F.lane + 64 * q; Y1[q] = p1[c8]; Y2[q] = p2[c8]; X[2 * q] = xp[2 * c8]; X[2 * q + 1] = xp[2 * c8 + 1]; }   \
        asm volatile("" ::: "memory"); __builtin_amdgcn_sched_barrier(0); } while (0)
#define MC_ROW(Y1, Y2, X, r_) do { const int li = 2 * ((r_) - c0); const float g1 = __builtin_bit_cast(float, __builtin_amdgcn_readlane(__builtin_bit_cast(int, tgv), li)), g2 = __builtin_bit_cast(float, __builtin_amdgcn_readlane(__builtin_bit_cast(int, tgv), li + 1)); \
        f32x4* xp = (f32x4*)(x + (size_t)(r_) * D);                                                                                                                        \
        _Pragma("unroll") for (int q = 0; q < 4; ++q) { const int c8 = F.lane + 64 * q; float a[8], b[8]; unpack8(Y1[q], a); unpack8(Y2[q], b);                             \
            const f32x4 m0 = {a[0] * g1 + b[0] * g2, a[1] * g1 + b[1] * g2, a[2] * g1 + b[2] * g2, a[3] * g1 + b[3] * g2}, m1 = {a[4] * g1 + b[4] * g2, a[5] * g1 + b[5] * g2, a[6] * g1 + b[6] * g2, a[7] * g1 + b[7] * g2}; \
            xp[2 * c8] = X[2 * q] + gm[2 * q] * m0; xp[2 * c8 + 1] = X[2 * q + 1] + gm[2 * q + 1] * m1; }                                                                    \
        asm volatile("" ::: "memory"); __builtin_amdgcn_sched_barrier(0); } while (0)
    for (int c0 = r0; c0 < r1; c0 += 32) {
        const int cn = min(32, r1 - c0);
        int rov = 0; float tgv = 0.f;
        if (F.lane < 2 * cn) { rov = ROWOF[2 * c0 + F.lane]; tgv = TOPG[2 * c0 + F.lane]; }
        for (int s0 = c0; s0 < c0 + cn;) {
            const int bat = s0 >> 11, send = min(c0 + cn, (bat + 1) << 11);
            f32x4 gm[8];
            { const f32x4* gp = (const f32x4*)(modl + (size_t)bat * 12288 + 5 * 2048);
#pragma unroll
              for (int q = 0; q < 4; ++q) { const int c8 = F.lane + 64 * q; gm[2 * q] = gp[2 * c8]; gm[2 * q + 1] = gp[2 * c8 + 1]; } }
            __builtin_amdgcn_s_waitcnt(0x0F70);
            v4u ya1[4], ya2[4], yb1[4], yb2[4]; f32x4 xa[8], xb[8];
            MC_LOAD(ya1, ya2, xa, s0);
            __builtin_amdgcn_s_waitcnt(0x0F70);
#pragma unroll 1
            for (int r = s0; r < send; r += 2) {
                __builtin_amdgcn_s_waitcnt(0x0F78);
                if (r + 1 < send) MC_LOAD(yb1, yb2, xb, r + 1);
                MC_ROW(ya1, ya2, xa, r);
                if (r + 1 < send) { __builtin_amdgcn_s_waitcnt(0x0F78); if (r + 2 < send) MC_LOAD(ya1, ya2, xa, r + 2); MC_ROW(yb1, yb2, xb, r + 1); }
            }
            __builtin_amdgcn_s_waitcnt(0x0F70);
            s0 = send;
        }
    }
#undef MC_LOAD
#undef MC_ROW
}

struct Args { const float* in[44]; float* out; unsigned char* ws; unsigned long long mask; };
__global__ void __launch_bounds__(NWAVES * 64, 2) fwd(Args args) {
    extern __shared__ __attribute__((aligned(16))) unsigned char lds[];
    Frame F;
    F.lds = (LAS unsigned char*)lds;
    F.MISC = (volatile LAS unsigned*)(F.lds + MISC_OFF);
    F.tid = threadIdx.x; F.lane = F.tid & 63; F.wave = __builtin_amdgcn_readfirstlane(F.tid >> 6);
    F.G = gridDim.x; F.out = args.out; F.ws = args.ws;
    F.ctl = (unsigned*)(F.ws + WS_CTL);
    for (int u = F.tid; u < 256; u += NWAVES * 64) ((LAS unsigned*)(F.lds + MISC_OFF))[u] = 0u;
    __syncthreads();
    XcdBarrier bar = xcd_barrier_post(F.ctl + CW_BAR, F.MISC + 8);
    const unsigned long long mask = args.mask;
#define RUN(p) ((mask >> (p)) & 1ull)
#define GRID_BAR() xcd_barrier(bar)
#define PH_BEGIN() do { int l_; asm volatile("v_mbcnt_lo_u32_b32 %0, -1, 0\n\tv_mbcnt_hi_u32_b32 %0, -1, %0" : "=v"(l_)); F.lane = l_; F.tid = F.wave * 64 + l_; __builtin_amdgcn_s_waitcnt(0x0F70); } while (0)
#ifndef PROBE_REP
#define PROBE_REP (-1)
#endif
#define PHASE(p) if (RUN(p)) for (int rep_ = 0; rep_ < (PROBE_REP == (p) ? 2 : 1); ++rep_)
#define MOD0 WSP(float, WS_MOD)
#define MOD1 (WSP(float, WS_MOD) + 9 * 12288)
#define XC WSP(float, WS_XC)
#define ACTA WSP(bf16, WS_ACTA)
#define ACTB WSP(bf16, WS_ACTB)
#define ACTC WSP(bf16, WS_ACTC)

    if (RUN(0)) { PH_BEGIN(); p0_ada(F); __syncthreads(); p0_rope_table(F); p0_transposes(F); GRID_BAR(); }

    if (RUN(21)) { PH_BEGIN(); copy_rows(F, KIN(0), F.out, (size_t)RL * D / 4); copy_rows(F, KIN(2), XC, (size_t)RC * D / 4); GRID_BAR(); }

#ifdef IN_F8
    PHASE(1) { PH_BEGIN(); norm_mod_rows<true>(F, KIN(0), KIN(2), KIN(6), MOD0, 0, 1, ACTA, RT); GRID_BAR(); }
#else
    PHASE(1) { PH_BEGIN(); norm_mod_rows(F, KIN(0), KIN(2), KIN(6), MOD0, 0, 1, ACTA, RT); GRID_BAR(); }
#endif
    PHASE(2) { PH_BEGIN();
#ifdef IN_F8
        pg8::Gemm g{ACTA, WSP(bf16, W_WIN), RT, NINP, D / 2}; pg8::StaticOrder S; S.init(RT, NINP, F.G, (int)blockIdx.x);
        pg8::EpiBf16G E{ACTB, NINP, 8, 1.0f / (SC_A8 * SC_W13)};
        pg8::gemm_phase<pg8::EpiBf16G, pg8::StaticOrder, true, true, true>(F.lds + RING_OFF, g, S, E, F.wave);
#else
        pg8::Gemm g{ACTA, WSP(bf16, W_WIN), RT, NINP, D}; pg8::StaticOrder S; S.init(RT, NINP, F.G, (int)blockIdx.x);
        pg8::EpiBf16G E{ACTB, NINP, 8};
        pg8::gemm_phase<pg8::EpiBf16G, pg8::StaticOrder, true, true>(F.lds + RING_OFF, g, S, E, F.wave);
#endif
        fill_tail(F, 0, (RT / 256) * (NINP / 256));
        GRID_BAR();
    }
    if (RUN(3)) { PH_BEGIN();
        for (;;) {
            if (F.tid == 0) F.MISC[16] = __hip_atomic_fetch_add(F.ctl + CW_Q3, 1u, __ATOMIC_RELAXED, __HIP_MEMORY_SCOPE_AGENT);
            __syncthreads();
            const int it = (int)F.MISC[16];
            __syncthreads();
            if (it >= RT / FT + 1152) break;
            if (it < RT / FT) { if (RUN(22)) feat_unit(F, it, ACTB, ACTA); } else sgu_unit(F, it - RT / FT, ACTB, ACTA);
        }
        if (!RUN(22)) zero_ab_right(F, ACTA);
        GRID_BAR();
    }
    if (RUN(4)) { PH_BEGIN();
#ifdef SCANP_REP
#pragma unroll 1
        for (int rep = 0; rep < SCANP_REP; ++rep)
#endif
        for (int u = blockIdx.x; u < 256; u += F.G) sc2::scan_unit2(F, u); GRID_BAR(); }
    PHASE(5) { PH_BEGIN(); readout_rows(F, ACTA); GRID_BAR(); }
    PHASE(6) { PH_BEGIN();
#ifdef WO0_F8
        pg8::Gemm g{ACTA, WSP(bf16, W_WO0), RT, D, D, D / 128}; pg8::StaticOrder S; S.init(RT, D, F.G, (int)blockIdx.x);
        pg8::EpiResGate E{KIN(0), KIN(2), F.out, XC, MOD0 + 2 * 2048, 1.0f / (SC_A8 * SC_W13)};
        pg8::gemm_phase<pg8::EpiResGate, pg8::StaticOrder, true, true, true>(F.lds + RING_OFF, g, S, E, F.wave);
#else
        pg8::Gemm g{ACTA, WSP(bf16, W_WO0), RT, D, D}; pg8::StaticOrder S; S.init(RT, D, F.G, (int)blockIdx.x);
        pg8::EpiResGate E{KIN(0), KIN(2), F.out, XC, MOD0 + 2 * 2048, 1.0f};
        pg8::gemm_phase<pg8::EpiResGate, pg8::StaticOrder, true, true>(F.lds + RING_OFF, g, S, E, F.wave);
#endif
        fill_tail(F, 1, (RT / 256) * (D / 256));
        GRID_BAR();
    }
#ifdef F13_F8
    PHASE(7) { PH_BEGIN(); norm_mod_rows<true>(F, F.out, XC, KIN(7), MOD0, 3, 4, ACTA, RT); GRID_BAR(); }
#else
    PHASE(7) { PH_BEGIN(); norm_mod_rows(F, F.out, XC, KIN(7), MOD0, 3, 4, ACTA, RT); GRID_BAR(); }
#endif
    PHASE(8) { PH_BEGIN();
#ifdef F13_F8
        pg8::Gemm g{ACTA, WSP(bf16, W_W13), RT, 2 * FF, D / 2}; pg8::StaticOrder S; S.init(RT, 2 * FF, F.G, (int)blockIdx.x);
#ifdef F2_BF16
        pg8::EpiSwiGLU E{ACTB, FF, 1.0f / (SC_A8 * SC_W13)};
        pg8::gemm_phase<pg8::EpiSwiGLU, pg8::StaticOrder, true, true, true>(F.lds + RING_OFF, g, S, E, F.wave);
#else
        pg8::EpiSwiGLU8 E{(unsigned char*)ACTB, FF, 1.0f / (SC_A8 * SC_W13)};
        pg8::gemm_phase<pg8::EpiSwiGLU8, pg8::StaticOrder, true, true, true>(F.lds + RING_OFF, g, S, E, F.wave);
#endif
#else
        pg8::Gemm g{ACTA, WSP(bf16, W_W13), RT, 2 * FF, D}; pg8::StaticOrder S; S.init(RT, 2 * FF, F.G, (int)blockIdx.x);
        pg8::EpiSwiGLU8 E{(unsigned char*)ACTB, FF, 1.0f};
        pg8::gemm_phase<pg8::EpiSwiGLU8, pg8::StaticOrder, true, true>(F.lds + RING_OFF, g, S, E, F.wave);
#endif
        fill_tail(F, 2, (RT / 256) * (2 * FF / 256));
        GRID_BAR();
    }
#if defined(PROBE_DRAIN) && defined(PROBE_DRAIN_AT9)
    if (blockIdx.x == 0 && F.tid == 0) { unsigned done = 0; for (int sh = 0; sh < 8; ++sh) { const unsigned q = __hip_atomic_load(F.ctl + CW_CQ + 64 * sh, __ATOMIC_RELAXED, __HIP_MEMORY_SCOPE_AGENT); done += q < (unsigned)(TI_NQ / 8) ? q : (unsigned)(TI_NQ / 8); }
        ((float*)(F.ctl + 2048))[0] = 1.0f - (float)done / (float)TI_NQ; }
#endif
    if (RUN(9)) { PH_BEGIN();
#ifdef F2_BF16
        pg8::Gemm g{ACTB, WSP(bf16, W_W2), RT, D, FF}; pg8::StaticOrder S; S.init(RT, D, F.G, (int)blockIdx.x);
        pg8::EpiResGate E{F.out, XC, F.out, XC, MOD0 + 5 * 2048, 1.0f};
        pg8::gemm_phase<pg8::EpiResGate, pg8::StaticOrder, true, true>(F.lds + RING_OFF, g, S, E, F.wave);
#else
        pg8::Gemm g{ACTB, WSP(bf16, W_W2), RT, D, FF / 2}; pg8::StaticOrder S; S.init(RT, D, F.G, (int)blockIdx.x);
        pg8::EpiResGate E{F.out, XC, F.out, XC, MOD0 + 5 * 2048, 1.0f / (SC_H8 * SC_W2)};
        pg8::gemm_phase<pg8::EpiResGate, pg8::StaticOrder, true, true, true>(F.lds + RING_OFF, g, S, E, F.wave);
#endif
        fill_tail(F, 3, (RT / 256) * (D / 256));
        GRID_BAR();
    }
#ifdef QKV_F8
    PHASE(10) { PH_BEGIN(); norm_mod_rows<true>(F, F.out, XC, KIN(29), MOD1, 0, 1, ACTA, RT); GRID_BAR(); }
#else
    PHASE(10) { PH_BEGIN(); norm_mod_rows(F, F.out, XC, KIN(29), MOD1, 0, 1, ACTA, RT); GRID_BAR(); }
#endif
#ifdef PROBE_NORM2
    { PH_BEGIN(); norm_mod_rows(F, KIN(0), KIN(2), KIN(29), MOD1, 0, 1, ACTC, RT); GRID_BAR(); }
#endif
    PHASE(11) { PH_BEGIN();
#ifdef QKV_F8
        pg8::Gemm g{ACTA, WSP(bf16, W_QKV), RT, 3 * D, D / 2}; pg8::StaticOrder S; S.init(RT, 3 * D, F.G, (int)blockIdx.x);
        pg8::EpiBf16S E{ACTB, 3 * D, 1.0f / (SC_A8 * SC_W13)};
        pg8::gemm_phase<pg8::EpiBf16S, pg8::StaticOrder, true, true, true>(F.lds + RING_OFF, g, S, E, F.wave);
#else
        pg8::Gemm g{ACTA, WSP(bf16, W_QKV), RT, 3 * D, D}; pg8::StaticOrder S; S.init(RT, 3 * D, F.G, (int)blockIdx.x);
        pg8::EpiBf16G E{ACTB, 3 * D, 0};
        pg8::gemm_phase<pg8::EpiBf16G, pg8::StaticOrder, true, true>(F.lds + RING_OFF, g, S, E, F.wave);
#endif
        fill_tail(F, 4, (RT / 256) * (3 * D / 256));
        GRID_BAR();
    }
    PHASE(12) { PH_BEGIN(); qknorm_rope_rows(F, ACTB); GRID_BAR(); }
    PHASE(13) { PH_BEGIN();
        float gq = fabsf(KIN(32)[F.lane]), gk = fabsf(KIN(33)[F.lane]);
#pragma unroll
        for (int o = 1; o < 64; o <<= 1) { gq = fmaxf(gq, __shfl_xor(gq, o)); gk = fmaxf(gk, __shfl_xor(gk, o)); }
        const float negM = -(8.0f * gq * gk * 1.4426950408889634f * 1.02f);
        const float s1 = wave_sum(KIN(34)[F.lane] * KIN(35)[F.lane]), s2 = wave_sum(KIN(36)[F.lane] * KIN(37)[F.lane]);
        const float lam_init = 0.8f - 0.6f * expf(-0.3f), lam = expf(s1) - expf(s2) + lam_init;
        if (negM > -96.0f) { for (int u = blockIdx.x; u < 1024; u += F.G) att::attn_unit<true>(F, u, ACTB, ACTA, negM, lam, 1.0f - lam_init); }
        else { for (int u = blockIdx.x; u < 1024; u += F.G) att::attn_unit<false>(F, u, ACTB, ACTA, negM, lam, 1.0f - lam_init); }
        GRID_BAR();
    }
    PHASE(15) { PH_BEGIN();
#ifdef WO1_F8
        pg8::Gemm g{ACTA, WSP(bf16, W_WO1), RL, D, D / 2}; pg8::StaticOrder S; S.init(RL, D, F.G, (int)blockIdx.x);
        pg8::EpiResGate E{F.out, nullptr, F.out, nullptr, MOD1 + 2 * 2048, 1.0f / (SC_A8 * SC_W13)};
        pg8::gemm_phase<pg8::EpiResGate, pg8::StaticOrder, true, true, true>(F.lds + RING_OFF, g, S, E, F.wave);
#else
        pg8::Gemm g{ACTA, WSP(bf16, W_WO1), RL, D, D}; pg8::StaticOrder S; S.init(RL, D, F.G, (int)blockIdx.x);
        pg8::EpiResGate E{F.out, nullptr, F.out, nullptr, MOD1 + 2 * 2048, 1.0f};
        pg8::gemm_phase<pg8::EpiResGate, pg8::StaticOrder, true, true>(F.lds + RING_OFF, g, S, E, F.wave);
#endif
        GRID_BAR();
    }
    PHASE(16) { PH_BEGIN(); moe_route_rows(F, F.out, KIN(30), MOD1, (unsigned char*)ACTA); GRID_BAR(); }
    if (RUN(17)) { PH_BEGIN(); moe_gather(F, (const unsigned char*)ACTA, (unsigned char*)ACTB); __syncthreads(); convert_queue(F, 0, 0u); GRID_BAR(); }
    PHASE(18) { PH_BEGIN();
        moe_layout(F, -1); LAS int* L = (LAS int*)(F.lds + LDS_MOE_OFF);
        pg8::Gemm g{ACTB, WSP(bf16, W_E13), 0, 0, D / 2}; pg8::GroupedOrder S; S.init(L[16], 2 * DE, F.G, (int)blockIdx.x, L + 32);
        pg8::EpiSwiGLU8 E{(unsigned char*)ACTC, DE, 1.0f / (SC_A8 * SC_W13)};
        pg8::gemm_phase<pg8::EpiSwiGLU8, pg8::GroupedOrder, true, true, true>(F.lds + RING_OFF, g, S, E, F.wave);
        GRID_BAR();
    }
    PHASE(19) { PH_BEGIN();
        moe_layout(F, -1); LAS int* L = (LAS int*)(F.lds + LDS_MOE_OFF);
        pg8::Gemm g{ACTC, WSP(bf16, W_E2), 0, 0, DE / 2}; pg8::GroupedOrder S; S.init(L[16], D, F.G, (int)blockIdx.x, L + 32);
        pg8::EpiBf16S E{WSP(bf16, WS_Y), D, 1.0f / (SC_H8 * SC_W2)};
#ifdef MOE_TAIL_SPLITK
        constexpr int SPL = 4; const int rem = S.nwg % F.G;
        if (rem > 0 && rem * SPL <= F.G) {
            S.lim = S.nwg - rem;
            pg8::gemm_phase<pg8::EpiBf16S, pg8::GroupedOrder, true, true, true>(F.lds + RING_OFF, g, S, E, F.wave);
            pg8::TailOrder T; T.base = S; T.L0 = S.nwg - rem; T.S = SPL; T.kslice = DE / SPL;
            pg8::Gemm g2 = g; g2.nt = (DE / 128) / SPL;
            pg8::EpiSplitK E2{(float*)ACTB};
            __syncthreads();
            pg8::gemm_phase<pg8::EpiSplitK, pg8::TailOrder, true, true, true>(F.lds + RING_OFF, g2, T, E2, F.wave);
            GRID_BAR();
            for (int t = blockIdx.x; t < rem; t += F.G) {
                pg8::Unit u; S.map(S.nwg - rem + t, u); const float* P0 = (const float*)ACTB + (size_t)(t * SPL) * 65536; const float sc = 1.0f / (SC_H8 * SC_W2);
                for (int i = F.tid; i < 65536 / 8; i += 512) { const int lr = i >> 5, lc = (i & 31) * 8; const float* p = P0 + (size_t)lr * 256 + lc;
                    f32x4 v0 = *(const f32x4*)p, v1 = *(const f32x4*)(p + 4);
#pragma unroll
                    for (int k = 1; k < SPL; ++k) { v0 = v0 + *(const f32x4*)(p + (size_t)k * 65536); v1 = v1 + *(const f32x4*)(p + (size_t)k * 65536 + 4); }
                    v0 = v0 * sc; v1 = v1 * sc;
                    v4u w; w.x = pk2(v0[0], v0[1]); w.y = pk2(v0[2], v0[3]); w.z = pk2(v1[0], v1[1]); w.w = pk2(v1[2], v1[3]);
                    *(v4u*)(WSP(bf16, WS_Y) + (size_t)(u.pm * 256 + lr) * D + u.pn * 256 + lc) = w; }
            }
        } else
#endif
        pg8::gemm_phase<pg8::EpiBf16S, pg8::GroupedOrder, true, true, true>(F.lds + RING_OFF, g, S, E, F.wave);
        GRID_BAR();
    }
    if (RUN(20)) { PH_BEGIN(); moe_combine_rows(F, F.out, MOD1, WSP(bf16, WS_Y));
#ifdef PROBE_DRAIN
        GRID_BAR(); { const float sc = 1.0f + PROBE_DRAIN * ((const float*)(F.ctl + 2048))[0]; for (size_t i = (size_t)blockIdx.x * 512 + F.tid; i < (size_t)RL * D; i += (size_t)F.G * 512) F.out[i] *= sc; }
#endif
    }
#undef RUN
#undef GRID_BAR
}

extern "C" void kernel_launch(void* const* d_in, const int* in_sizes, int n_in, void* d_out, int out_size, void* d_ws, size_t ws_size, hipStream_t stream) {
    static int grid = 0;
    if (grid == 0) {
        if (n_in != 44 || in_sizes[0] != RL * D || out_size != RL * D || ws_size < WS_END) {
            fprintf(stderr, "kernel_launch: shape mismatch: n_in %d in0 %d out %d ws %zu (need %zu)\n", n_in, n_in > 0 ? in_sizes[0] : -1, out_size, ws_size, (size_t)WS_END); grid = -1; return; }
        int dev = 0, cus = 0, per_cu = 0;
        if (hipGetDevice(&dev) != hipSuccess || hipDeviceGetAttribute(&cus, hipDeviceAttributeMultiprocessorCount, dev) != hipSuccess) { grid = -1; return; }
        if (hipFuncSetAttribute((const void*)fwd, hipFuncAttributeMaxDynamicSharedMemorySize, LDS_BYTES) != hipSuccess) { fprintf(stderr, "kernel_launch: hipFuncSetAttribute failed\n"); grid = -1; return; }
        if (hipOccupancyMaxActiveBlocksPerMultiprocessor(&per_cu, (const void*)fwd, NWAVES * 64, LDS_BYTES) != hipSuccess || per_cu < 1) { fprintf(stderr, "kernel_launch: occupancy query says %d\n", per_cu); }
        (void)hipGetLastError();
        grid = cus;
    }
    if (grid < 0) return;
    if (hipMemsetAsync((char*)d_ws + WS_CTL, 0, CTL_ZERO_BYTES, stream) != hipSuccess) return;
    Args a{};
    for (int i = 0; i < 44; ++i) a.in[i] = (const float*)d_in[i];
    a.out = (float*)d_out; a.ws = (unsigned char*)d_ws; a.mask = PHASE_MASK;
    hipLaunchKernelGGL(fwd, dim3(grid), dim3(NWAVES * 64), LDS_BYTES, stream, a);
    const hipError_t le = hipPeekAtLastError();
    if (le != hipSuccess) fprintf(stderr, "kernel_launch: launch failed: %s\n", hipGetErrorName(le));
}
```

```cpp
#define PHASE_MASK (0x1FFFFFull|(1ull<<22))
#define QKV_F8 1
#define MOE_TAIL_SPLITK 1
#define SCAN_CVPIPE 1
#define F13_F8 1
#define SCAN_HPRIO 1
#define QGRAB 4
#define ATT_3BUF 1
#include <hip/hip_runtime.h>
#include <cstdio>
#include <cstdint>

#define GAS __attribute__((address_space(1)))
#define LAS __attribute__((address_space(3)))
typedef unsigned short bf16;
typedef unsigned v4u __attribute__((ext_vector_type(4)));
typedef unsigned v2u __attribute__((ext_vector_type(2)));
typedef float f32x4 __attribute__((ext_vector_type(4)));
typedef float f32x2 __attribute__((ext_vector_type(2)));
typedef short bf16x8 __attribute__((ext_vector_type(8)));
typedef float f32x16 __attribute__((ext_vector_type(16)));
typedef short s16x4 __attribute__((ext_vector_type(4)));
#define LDS_WAIT() asm volatile("s_waitcnt lgkmcnt(0)" ::: "memory")
#define VM_WAIT() asm volatile("s_waitcnt vmcnt(0)" ::: "memory")

constexpr int D = 2048, NB = 8, SEQ = 2048, CTX = 256;
constexpr int RL = NB * SEQ, RC = NB * CTX, RT = RL + RC;
constexpr int MIXA = 1024, MIXB = 1024, NIN = 5408, NINP = 5632, ZB = 2048;
constexpr int FF = 5632, DE = 7168, NE = 8;
constexpr int MAXP = 136;
constexpr int MOEROWS = MAXP * 256;

constexpr size_t MiB = 1u << 20;
constexpr size_t WS_CTL = 0, CTL_ZERO_BYTES = 1 * MiB;
constexpr size_t WS_MOD = 1 * MiB;
constexpr size_t WS_SMALLW = 2 * MiB;
constexpr size_t WS_ROUTE = 3 * MiB;
constexpr size_t WS_W = 4 * MiB;
constexpr size_t W_WIN = WS_W, W_WO0 = W_WIN + (size_t)NINP * D * 2, W_W13 = W_WO0 + (size_t)D * D * 2, W_W2 = W_W13 + (size_t)2 * FF * D * 2,
                 W_QKV = W_W2 + (size_t)D * FF * 2, W_WO1 = W_QKV + (size_t)3 * D * D * 2, W_E13 = W_WO1 + (size_t)D * D * 2, W_E2 = W_E13 + (size_t)NE * 2 * DE * D,
                 W_END = W_E13 + 672 * MiB;
static_assert(W_END == 804 * MiB, "weight region = 800 MiB");
constexpr size_t WS_ACTA = 804 * MiB;
constexpr size_t WS_ACTB = WS_ACTA + 72 * MiB;
constexpr size_t WS_ACTC = WS_ACTB + 216 * MiB;
constexpr size_t WS_XC = WS_ACTC + 476 * MiB;
constexpr size_t WS_END = WS_XC + 16 * MiB;
constexpr size_t WS_Y = W_E13 + 336 * MiB;
static_assert(W_E2 + (size_t)NE * D * DE <= WS_Y && WS_Y + (size_t)MOEROWS * D * 4 <= W_END, "Y fits behind the fp8 expert weights");
constexpr float SC_A8 = 8.0f, SC_W13 = 64.0f, SC_H8 = 4.0f, SC_W2 = 128.0f;
static_assert((size_t)MOEROWS * DE * 2 <= 476 * MiB && (size_t)MOEROWS * D * 2 <= 216 * MiB, "MoE buffers fit");
constexpr size_t FEAT_SZ = (size_t)RT * 1024 * 2;
constexpr int CW_TMO = 0;
constexpr int CW_BAR = 4096;
constexpr int CW_Q3 = 64;
constexpr int CW_CQ = 128;
constexpr int CW_TAIL = 16384;
constexpr int CW_DONE = 1024;
constexpr size_t RO_TOPI = 0, RO_TOPG = 128 * 1024, RO_LRANK = 256 * 1024, RO_CNT = 384 * 1024, RO_ROWOF = 512 * 1024;

constexpr int NWAVES = 8;
constexpr int LDS_BYTES = 160 * 1024;
constexpr int RING_OFF = 0, RING_BYTES = 131072, MISC_OFF = 159 * 1024;

__device__ __forceinline__ unsigned f2bf(float f) { unsigned u = __builtin_bit_cast(unsigned, f); return (u + 0x7fffu + ((u >> 16) & 1u)) >> 16; }
typedef __bf16 bf16x2_t __attribute__((ext_vector_type(2)));
__device__ __forceinline__ unsigned pk2(float lo, float hi) { const f32x2 v = {lo, hi}; return __builtin_bit_cast(unsigned, __builtin_convertvector(v, bf16x2_t)); }
__device__ __forceinline__ float bf2f(unsigned short b) { return __builtin_bit_cast(float, (unsigned)b << 16); }
__device__ __forceinline__ float bflo(unsigned w) { return __builtin_bit_cast(float, w << 16); }
__device__ __forceinline__ float bfhi(unsigned w) { return __builtin_bit_cast(float, w & 0xffff0000u); }
__device__ __forceinline__ float wave_sum(float v) {
#pragma unroll
    for (int o = 1; o < 64; o <<= 1) v += __shfl_xor(v, o);
    return v;
}
__device__ __forceinline__ float fast_exp(float x) { return __builtin_amdgcn_exp2f(x * 1.4426950408889634f); }
__device__ __forceinline__ float fast_sigmoid(float x) { return __builtin_amdgcn_rcpf(1.0f + __builtin_amdgcn_exp2f(-x * 1.4426950408889634f)); }
__device__ __forceinline__ float silu_f(float x) { return x * fast_sigmoid(x); }
__device__ __forceinline__ float gelu_tanh_f(float x) { const float z = 0.7978845608028654f * (x + 0.044715f * x * x * x); return x * fast_sigmoid(2.0f * z); }

typedef int v8i32 __attribute__((ext_vector_type(8)));
typedef int v4i32 __attribute__((ext_vector_type(4)));
__device__ __forceinline__ v8i32 cat8(bf16x8 a, bf16x8 b) { const v4i32 x = __builtin_bit_cast(v4i32, a), y = __builtin_bit_cast(v4i32, b); return __builtin_shufflevector(x, y, 0, 1, 2, 3, 4, 5, 6, 7); }
__device__ __forceinline__ float clamp8(float x) { return __builtin_amdgcn_fmed3f(x, -448.0f, 448.0f); }
__device__ __forceinline__ unsigned pk4_fp8(float a, float b, float c, float d) {
    int w = 0; w = __builtin_amdgcn_cvt_pk_fp8_f32(clamp8(a), clamp8(b), w, false); w = __builtin_amdgcn_cvt_pk_fp8_f32(clamp8(c), clamp8(d), w, true); return (unsigned)w; }
__device__ __forceinline__ void mfma_f8_tied(f32x4& acc, v8i32 a, v8i32 b, int sc) {
    asm volatile("v_mfma_scale_f32_16x16x128_f8f6f4 %0, %1, %2, %0, %3, %3 op_sel_hi:[0,0,0]" : "+v"(acc) : "v"(a), "v"(b), "v"(sc));
}
namespace pg8 {
#define PG8_LAS __attribute__((address_space(3)))
typedef unsigned short bf16_t;
typedef short bf16x8 __attribute__((ext_vector_type(8)));
typedef float f32x4 __attribute__((ext_vector_type(4)));
typedef unsigned u32x4 __attribute__((ext_vector_type(4)));
constexpr int BM = 256, BK = 64, HALF = 128, HTB = HALF * BK * 2, STAGE_BYTES = 8 * HTB, NXCD = 8, WGM = 8;
__host__ __device__ __forceinline__ int lds_byte(int r, int c) { const int st = (r >> 4) * 2 + (c >> 5), rr = r & 15, cc = c & 31, ob = rr * 64 + cc * 2; return st * 1024 + (ob ^ (((ob >> 9) & 1) << 5)); }
__host__ __device__ __forceinline__ void stage_rc(int b, int& R, int& C) { const int st = b / 1024, sb = b % 1024, swz = sb ^ (((sb >> 9) & 1) << 5); R = (st >> 1) * 16 + swz / 64; C = (st & 1) * 32 + (swz % 64) / 2; }
__host__ __device__ __forceinline__ int perm32(int rho) { const int n = rho >> 4, i = rho & 15; return 8 * (i >> 2) + 4 * n + (i & 3); }
struct Unit { int pm, pn, pb, ko, tj; };
struct Gemm { const bf16_t* A; const bf16_t* Bt; int M, N, K; int nt = 0; };
struct StaticOrder {
    int nM, nN, nwg, G, c;
    __host__ __device__ void init(int M, int N, int G_, int c_) { nM = M / BM; nN = N / BM; nwg = nM * nN; G = G_; c = c_; }
    __host__ __device__ bool next(int i, Unit& u) const {
        const long L = (long)i * G + c; if (L >= nwg) return false;
        int wgid = (int)L; { const int q = nwg / NXCD, r = nwg % NXCD, xcd = wgid % NXCD, off = wgid / NXCD; wgid = (xcd < r ? xcd * (q + 1) : r * (q + 1) + (xcd - r) * q) + off; }
        const int nig = WGM * nN, gid = wgid / nig, fm = gid * WGM, gsz = (nM - fm) < WGM ? (nM - fm) : WGM;
        u.pm = fm + ((wgid % nig) % gsz); u.pn = (wgid % nig) / gsz; u.pb = u.pn; u.ko = 0; u.tj = 0; return true;
    }
    __device__ __forceinline__ void a_ready(const Unit&) const {}
    __device__ __forceinline__ void done(const Unit&) const {}
};
struct GroupedOrder {
    int nM, nN, nwg, G, c, lim; const LAS int* ptab;
    __device__ void init(int nPanels, int N, int G_, int c_, const LAS int* pt) { nM = nPanels; nN = N / BM; nwg = nM * nN; G = G_; c = c_; ptab = pt; lim = nwg; }
    __device__ __forceinline__ void map(int L, Unit& u) const {
        int wgid = L; { const int q = nwg / NXCD, r = nwg % NXCD, xcd = wgid % NXCD, off = wgid / NXCD; wgid = (xcd < r ? xcd * (q + 1) : r * (q + 1) + (xcd - r) * q) + off; }
        const int nig = WGM * nN, gid = wgid / nig, fm = gid * WGM, gsz = (nM - fm) < WGM ? (nM - fm) : WGM;
        u.pm = fm + ((wgid % nig) % gsz); u.pn = (wgid % nig) / gsz; u.pb = __builtin_amdgcn_readfirstlane(ptab[u.pm]) * nN + u.pn; u.ko = 0; u.tj = 0;
    }
    __device__ __forceinline__ bool next(int i, Unit& u) const { const long L = (long)i * G + c; if (L >= lim) return false; map((int)L, u); return true; }
    __device__ __forceinline__ void a_ready(const Unit&) const {}
    __device__ __forceinline__ void done(const Unit&) const {}
};
struct TailOrder {
    GroupedOrder base; int L0, S, kslice;
    __device__ __forceinline__ bool next(int i, Unit& u) const { if (i > 0 || base.c >= (base.nwg - L0) * S) return false; base.map(L0 + base.c / S, u); u.ko = (base.c % S) * kslice; u.tj = base.c; return true; }
    __device__ __forceinline__ void a_ready(const Unit&) const {}
    __device__ __forceinline__ void done(const Unit&) const {}
};
__device__ __forceinline__ unsigned cvt_pk_bf16(float lo, float hi) { unsigned r; asm volatile("v_cvt_pk_bf16_f32 %0, %1, %2" : "=v"(r) : "v"(lo), "v"(hi)); return r; }

struct EpiBf16G {
    static constexpr bool PERM = true, AFTER_DRAIN = false;
    bf16_t* O; int ldc; int gelu_tiles; float scale = 1.0f;
    __device__ __forceinline__ void operator()(const f32x4 (&acc)[2][2][4][2], const Unit& u, int wr, int wc, int fr, int fq) const {
        const int row0 = u.pm * BM + wr * 64 + fr, col0 = u.pn * BM + wc * 32 + 8 * fq; const bool act = u.pn < gelu_tiles;
#pragma unroll
        for (int ai = 0; ai < 2; ++ai)
#pragma unroll
            for (int m = 0; m < 4; ++m) { bf16_t* rowp = O + (size_t)(row0 + ai * HALF + m * 16) * ldc + col0;
#pragma unroll
                for (int bj = 0; bj < 2; ++bj) { f32x4 v0 = acc[ai][bj][m][0] * scale, v1 = acc[ai][bj][m][1] * scale;
                    if (act) {
#pragma unroll
                        for (int j = 0; j < 4; ++j) { v0[j] = gelu_tanh_f(v0[j]); v1[j] = gelu_tanh_f(v1[j]); } }
                    u32x4 w; w.x = cvt_pk_bf16(v0[0], v0[1]); w.y = cvt_pk_bf16(v0[2], v0[3]); w.z = cvt_pk_bf16(v1[0], v1[1]); w.w = cvt_pk_bf16(v1[2], v1[3]);
                    *(u32x4*)(rowp + bj * HALF) = w; } }
    }
};
struct EpiSwiGLU {
    static constexpr bool PERM = true, AFTER_DRAIN = false;
    bf16_t* O; int ldc; float is = 1.0f;
    __device__ __forceinline__ void operator()(const f32x4 (&acc)[2][2][4][2], const Unit& u, int wr, int wc, int fr, int fq) const {
        const int row0 = u.pm * BM + wr * 64 + fr, col0 = u.pn * HALF + wc * 32 + 8 * fq;
#pragma unroll
        for (int ai = 0; ai < 2; ++ai)
#pragma unroll
            for (int m = 0; m < 4; ++m) { bf16_t* rowp = O + (size_t)(row0 + ai * HALF + m * 16) * ldc + col0;
                f32x4 v0, v1;
#pragma unroll
                for (int j = 0; j < 4; ++j) { v0[j] = silu_f(acc[ai][0][m][0][j] * is) * (acc[ai][1][m][0][j] * is); v1[j] = silu_f(acc[ai][0][m][1][j] * is) * (acc[ai][1][m][1][j] * is); }
                u32x4 w; w.x = cvt_pk_bf16(v0[0], v0[1]); w.y = cvt_pk_bf16(v0[2], v0[3]); w.z = cvt_pk_bf16(v1[0], v1[1]); w.w = cvt_pk_bf16(v1[2], v1[3]);
                *(u32x4*)rowp = w; }
    }
};
struct EpiResGate {
    static constexpr bool PERM = false, AFTER_DRAIN = false;
    const float* res_l; const float* res_c; float* out_l; float* out_c; const float* gate; float scale;
    __device__ __forceinline__ void operator()(const f32x4 (&acc)[2][2][4][2], const Unit& u, int wr, int wc, int fr, int fq) const {
        const bool lat = u.pm < 64; const int mrow = lat ? (u.pm >> 3) : 8; const size_t pbase = (size_t)(lat ? u.pm : u.pm - 64) * BM * 2048;
        const float* rb = (lat ? res_l : res_c) + pbase; float* ob = (lat ? out_l : out_c) + pbase; const float* gp = gate + (size_t)mrow * (6 * 2048);
        const int row0 = wr * 64 + fr, col0 = u.pn * BM + wc * 32 + 4 * fq;
        f32x4 gv[2][2];
#pragma unroll
        for (int bj = 0; bj < 2; ++bj)
#pragma unroll
            for (int n = 0; n < 2; ++n) gv[bj][n] = *(const f32x4*)(gp + col0 + bj * HALF + n * 16) * scale;
        f32x4 rc[2][2], rn[2][2];
#pragma unroll
        for (int bj = 0; bj < 2; ++bj)
#pragma unroll
            for (int n = 0; n < 2; ++n) rc[bj][n] = *(const f32x4*)(rb + (size_t)row0 * 2048 + col0 + bj * HALF + n * 16);
#pragma unroll
        for (int idx = 0; idx < 8; ++idx) { const int ai = idx >> 2, m = idx & 3; const size_t off = (size_t)(row0 + ai * HALF + m * 16) * 2048 + col0;
            if (idx + 1 < 8) { const int ai1 = (idx + 1) >> 2, m1 = (idx + 1) & 3; const size_t off1 = (size_t)(row0 + ai1 * HALF + m1 * 16) * 2048 + col0;
#pragma unroll
                for (int bj = 0; bj < 2; ++bj)
#pragma unroll
                    for (int n = 0; n < 2; ++n) rn[bj][n] = *(const f32x4*)(rb + off1 + bj * HALF + n * 16); }
#pragma unroll
            for (int bj = 0; bj < 2; ++bj)
#pragma unroll
                for (int n = 0; n < 2; ++n) { *(f32x4*)(ob + off + bj * HALF + n * 16) = rc[bj][n] + gv[bj][n] * acc[ai][bj][m][n]; rc[bj][n] = rn[bj][n]; }
            asm volatile("" ::: "memory"); }
    }
};
struct EpiF32 {
    static constexpr bool PERM = false, AFTER_DRAIN = false;
    float* C; int ldc;
    __device__ __forceinline__ void operator()(const f32x4 (&acc)[2][2][4][2], const Unit& u, int wr, int wc, int fr, int fq) const {
        const int row0 = u.pm * BM + wr * 64 + fr, col0 = u.pn * BM + wc * 32 + 4 * fq;
#pragma unroll
        for (int ai = 0; ai < 2; ++ai)
#pragma unroll
            for (int m = 0; m < 4; ++m) { float* rowp = C + (size_t)(row0 + ai * HALF + m * 16) * ldc + col0;
#pragma unroll
                for (int bj = 0; bj < 2; ++bj)
#pragma unroll
                    for (int n = 0; n < 2; ++n) *(f32x4*)(rowp + bj * HALF + n * 16) = acc[ai][bj][m][n]; }
    }
};
struct EpiSwiGLU8 {
    static constexpr bool PERM = true, AFTER_DRAIN = false;
    unsigned char* O; int ldc; float is;
    __device__ __forceinline__ void operator()(const f32x4 (&acc)[2][2][4][2], const Unit& u, int wr, int wc, int fr, int fq) const {
        const int row0 = u.pm * BM + wr * 64 + fr, col0 = u.pn * HALF + wc * 32 + 8 * fq; const float ke = -1.4426950408889634f * is, kq = is * is * SC_H8;
#pragma unroll
        for (int ai = 0; ai < 2; ++ai)
#pragma unroll
            for (int m = 0; m < 4; ++m) { unsigned char* rowp = O + (size_t)(row0 + ai * HALF + m * 16) * ldc + col0;
                f32x4 v0, v1;
#pragma unroll
                for (int j = 0; j < 4; ++j) {
                    const float g0 = acc[ai][0][m][0][j], g1 = acc[ai][0][m][1][j];
                    v0[j] = (g0 * acc[ai][1][m][0][j]) * (kq * __builtin_amdgcn_rcpf(1.0f + __builtin_amdgcn_exp2f(g0 * ke)));
                    v1[j] = (g1 * acc[ai][1][m][1][j]) * (kq * __builtin_amdgcn_rcpf(1.0f + __builtin_amdgcn_exp2f(g1 * ke))); }
                v2u w; w.x = pk4_fp8(v0[0], v0[1], v0[2], v0[3]); w.y = pk4_fp8(v1[0], v1[1], v1[2], v1[3]);
                *(v2u*)rowp = w; }
    }
};
struct EpiF32S {
    static constexpr bool PERM = false, AFTER_DRAIN = false;
    float* C; int ldc; float scale;
    __device__ __forceinline__ void operator()(const f32x4 (&acc)[2][2][4][2], const Unit& u, int wr, int wc, int fr, int fq) const {
        const int row0 = u.pm * BM + wr * 64 + fr, col0 = u.pn * BM + wc * 32 + 4 * fq;
#pragma unroll
        for (int ai = 0; ai < 2; ++ai)
#pragma unroll
            for (int m = 0; m < 4; ++m) { float* rowp = C + (size_t)(row0 + ai * HALF + m * 16) * ldc + col0;
#pragma unroll
                for (int bj = 0; bj < 2; ++bj)
#pragma unroll
                    for (int n = 0; n < 2; ++n) *(f32x4*)(rowp + bj * HALF + n * 16) = acc[ai][bj][m][n] * scale; }
    }
};
struct EpiBf16S {
    static constexpr bool PERM = true, AFTER_DRAIN = false;
    bf16_t* O; int ldc; float scale;
    __device__ __forceinline__ void operator()(const f32x4 (&acc)[2][2][4][2], const Unit& u, int wr, int wc, int fr, int fq) const {
        const int row0 = u.pm * BM + wr * 64 + fr, col0 = u.pn * BM + wc * 32 + 8 * fq;
#pragma unroll
        for (int ai = 0; ai < 2; ++ai)
#pragma unroll
            for (int m = 0; m < 4; ++m) { bf16_t* rowp = O + (size_t)(row0 + ai * HALF + m * 16) * ldc + col0;
#pragma unroll
                for (int bj = 0; bj < 2; ++bj) { const f32x4 v0 = acc[ai][bj][m][0] * scale, v1 = acc[ai][bj][m][1] * scale;
                    u32x4 w; w.x = cvt_pk_bf16(v0[0], v0[1]); w.y = cvt_pk_bf16(v0[2], v0[3]); w.z = cvt_pk_bf16(v1[0], v1[1]); w.w = cvt_pk_bf16(v1[2], v1[3]);
                    *(u32x4*)(rowp + bj * HALF) = w; } }
    }
};
struct EpiSplitK {
    static constexpr bool PERM = true, AFTER_DRAIN = false;
    float* P;
    __device__ __forceinline__ void operator()(const f32x4 (&acc)[2][2][4][2], const Unit& u, int wr, int wc, int fr, int fq) const {
        float* Pt = P + (size_t)u.tj * 65536; const int lr0 = wr * 64 + fr, lc0 = wc * 32 + 8 * fq;
#pragma unroll
        for (int ai = 0; ai < 2; ++ai)
#pragma unroll
            for (int m = 0; m < 4; ++m)
#pragma unroll
                for (int bj = 0; bj < 2; ++bj) { float* p = Pt + (size_t)(lr0 + ai * HALF + m * 16) * 256 + lc0 + bj * HALF; *(f32x4*)p = acc[ai][bj][m][0]; *(f32x4*)(p + 4) = acc[ai][bj][m][1]; }
    }
};
template <class Epi, class Sched, bool ALIGN_EPI = false, bool SP2 = false, bool F8 = false>
__device__ __forceinline__ void gemm_phase(PG8_LAS unsigned char* lds, const Gemm g, const Sched& S, const Epi& E, const int wid) {
    const int lane = (int)__builtin_amdgcn_mbcnt_hi(~0u, __builtin_amdgcn_mbcnt_lo(~0u, 0u)), tid = wid * 64 + lane, wr = wid >> 2, wc = wid & 3, fr = lane & 15, fq = lane >> 4;
    const int K = g.K, nt = g.nt ? g.nt : K / BK;
    unsigned voffA[2], voffB[2];
#pragma unroll
    for (int i = 0; i < 2; ++i) { int R, C; stage_rc(tid * 16 + i * 8192, R, C); const int Rb = Epi::PERM ? ((R & ~31) + perm32(R & 31)) : R;
        voffA[i] = (unsigned)(R * K + C) * 2u; voffB[i] = (unsigned)(Rb * K + C) * 2u; }
    const size_t kstep = (size_t)(BK * 2);
    const size_t hstep = (size_t)HALF * K * 2;
    const size_t tstep = 2 * hstep;
    const unsigned ldsw = (unsigned)wid * 1024u;
    const int aoff = lds_byte(wr * 64 + fr, fq * 8), boff = lds_byte(wc * 32 + fr, fq * 8);
#define PG8_SA(b, h) (((b) * 2 + (h)) * HTB)
#define PG8_SB(b, h) ((4 + (b) * 2 + (h)) * HTB)
    const __amdgpu_buffer_rsrc_t rsrcA = __builtin_amdgcn_make_buffer_rsrc((void*)g.A, 0, -1, 0x00020000), rsrcB = __builtin_amdgcn_make_buffer_rsrc((void*)g.Bt, 0, -1, 0x00020000);
#define PG8_STAGE(bufoff, gbase, voff) do { if constexpr (F8) { const bool _isA = ((voff) == voffA); const int _so = (int)(unsigned)((const char*)(gbase) - (const char*)(_isA ? (const void*)g.A : (const void*)g.Bt)); \
        _Pragma("unroll") for (int _i = 0; _i < 2; ++_i) __builtin_amdgcn_raw_ptr_buffer_load_lds(_isA ? rsrcA : rsrcB, (PG8_LAS unsigned*)(lds + (bufoff) + ldsw + _i * 8192), 16, (int)(voff)[_i], _so, 0, 0); } \
      else { _Pragma("unroll") for (int _i = 0; _i < 2; ++_i) \
        __builtin_amdgcn_global_load_lds((const unsigned*)((const char*)(gbase) + (voff)[_i]), (PG8_LAS unsigned*)(lds + (bufoff) + ldsw + _i * 8192), 16, 0, 0); } } while (0)
#define PG8_LDA(dst, b, h) do { _Pragma("unroll") for (int m = 0; m < 4; ++m) _Pragma("unroll") for (int k = 0; k < 2; ++k) dst[m][k] = *(const PG8_LAS bf16x8*)(lds + PG8_SA(b, h) + aoff + m * 2048 + k * 1024); } while (0)
#define PG8_LDB(dst, b, h) do { _Pragma("unroll") for (int n = 0; n < 2; ++n) _Pragma("unroll") for (int k = 0; k < 2; ++k) dst[n][k] = *(const PG8_LAS bf16x8*)(lds + PG8_SB(b, h) + boff + n * 2048 + k * 1024); } while (0)
#define PG8_MMAZ(ai, bj, At, Bt, Z) do { __builtin_amdgcn_s_setprio(1); \
        if constexpr (F8) { _Pragma("unroll") for (int m = 0; m < 4; ++m) _Pragma("unroll") for (int n = 0; n < 2; ++n) \
            mfma_f8_tied(acc[ai][bj][m][n], cat8(Bt[n][0], Bt[n][1]), cat8(At[m][0], At[m][1]), f8scale); } \
        else { _Pragma("unroll") for (int m = 0; m < 4; ++m) _Pragma("unroll") for (int n = 0; n < 2; ++n) _Pragma("unroll") for (int k = 0; k < 2; ++k) \
            acc[ai][bj][m][n] = __builtin_amdgcn_mfma_f32_16x16x32_bf16(Bt[n][k], At[m][k], ((Z) && k == 0) ? (f32x4){0.f, 0.f, 0.f, 0.f} : acc[ai][bj][m][n], 0, 0, 0); } \
        __builtin_amdgcn_s_setprio(0); } while (0)
#define PG8_MMA(ai, bj, At, Bt) PG8_MMAZ(ai, bj, At, Bt, false)
#define PG8_WAIT_V(n) asm volatile("s_waitcnt vmcnt(" #n ")" ::: "memory")
#define PG8_WAIT_L(n) asm volatile("s_waitcnt lgkmcnt(" #n ")" ::: "memory")
#define PG8_BAR __builtin_amdgcn_s_barrier()
#define PG8_SCHED __builtin_amdgcn_sched_barrier(0)
#define PG8_KBODY(ZF) \
            const bool last = (t == nt - 2); \
            const char* a1 = cA + (size_t)(t + 1) * kstep; \
            const char* a2 = last ? nA : cA + (size_t)(t + 2) * kstep; const char* b2 = last ? nB : cB + (size_t)(t + 2) * kstep; \
            const char* a3 = a2 + kstep; const char* b3 = b2 + kstep; \
            if (last && has_next) S.a_ready(nxt); \
            if constexpr (SP2) { \
            PG8_LDB(B0, 0, 0); PG8_LDB(B1, 0, 1); PG8_SCHED; PG8_LDA(At, 0, 0); PG8_STAGE(PG8_SA(1, 1), a1 + hstep, voffA); \
            PG8_WAIT_V(8); PG8_WAIT_L(0); PG8_BAR; PG8_MMAZ(0, 0, At, B0, ZF); PG8_MMAZ(0, 1, At, B1, ZF); PG8_BAR; PG8_SCHED; \
            PG8_LDA(At, 0, 1); PG8_STAGE(PG8_SB(0, 0), b2, voffB); PG8_STAGE(PG8_SB(0, 1), b2 + hstep, voffB); PG8_STAGE(PG8_SA(0, 0), a2, voffA); \
            PG8_WAIT_V(8); PG8_WAIT_L(0); PG8_BAR; PG8_MMAZ(1, 0, At, B0, ZF); PG8_MMAZ(1, 1, At, B1, ZF); PG8_BAR; PG8_SCHED; \
            PG8_LDB(B0, 1, 0); PG8_LDB(B1, 1, 1); PG8_SCHED; PG8_LDA(At, 1, 0); PG8_STAGE(PG8_SA(0, 1), a2 + hstep, voffA); \
            PG8_WAIT_V(8); PG8_WAIT_L(0); PG8_BAR; PG8_MMA(0, 0, At, B0); PG8_MMA(0, 1, At, B1); PG8_BAR; PG8_SCHED; \
            PG8_LDA(At, 1, 1); PG8_STAGE(PG8_SB(1, 0), b3, voffB); PG8_STAGE(PG8_SB(1, 1), b3 + hstep, voffB); PG8_STAGE(PG8_SA(1, 0), a3, voffA); \
            PG8_WAIT_V(8); PG8_WAIT_L(0); PG8_BAR; PG8_MMA(1, 0, At, B0); PG8_MMA(1, 1, At, B1); PG8_BAR; PG8_SCHED; \
            } else { \
            PG8_LDB(B0, 0, 0); PG8_SCHED; PG8_LDA(At, 0, 0); PG8_STAGE(PG8_SA(1, 1), a1 + hstep, voffA); \
            PG8_WAIT_L(8); PG8_BAR; PG8_WAIT_L(0); PG8_MMAZ(0, 0, At, B0, ZF); PG8_BAR; PG8_SCHED; \
            PG8_LDB(B1, 0, 1); PG8_STAGE(PG8_SB(0, 0), b2, voffB); \
            PG8_BAR; PG8_WAIT_L(0); PG8_MMAZ(0, 1, At, B1, ZF); PG8_BAR; \
            PG8_LDA(At, 0, 1); PG8_STAGE(PG8_SA(0, 0), a2, voffA); \
            PG8_BAR; PG8_WAIT_L(0); PG8_MMAZ(1, 0, At, B0, ZF); PG8_BAR; PG8_SCHED; \
            PG8_STAGE(PG8_SB(0, 1), b2 + hstep, voffB); \
            PG8_WAIT_V(6); PG8_BAR; PG8_MMAZ(1, 1, At, B1, ZF); PG8_BAR; \
            PG8_LDB(B0, 1, 0); PG8_SCHED; PG8_LDA(At, 1, 0); PG8_STAGE(PG8_SA(0, 1), a2 + hstep, voffA); \
            PG8_WAIT_L(8); PG8_BAR; PG8_WAIT_L(0); PG8_MMA(0, 0, At, B0); PG8_BAR; PG8_SCHED; \
            PG8_LDB(B1, 1, 1); PG8_STAGE(PG8_SB(1, 0), b3, voffB); \
            PG8_BAR; PG8_WAIT_L(0); PG8_MMA(0, 1, At, B1); PG8_BAR; \
            PG8_LDA(At, 1, 1); PG8_STAGE(PG8_SA(1, 0), a3, voffA); \
            PG8_BAR; PG8_WAIT_L(0); PG8_MMA(1, 0, At, B0); PG8_BAR; PG8_SCHED; \
            PG8_STAGE(PG8_SB(1, 1), b3 + hstep, voffB); \
            PG8_WAIT_V(6); PG8_BAR; PG8_MMA(1, 1, At, B1); PG8_BAR; \
            }
    Unit cur, nxt; int ui = 0;
    if (!S.next(0, cur)) return;
    f32x4 acc[2][2][4][2];
    int f8scale = 0x7F7F7F7F; if constexpr (F8) asm volatile("" : "+v"(f8scale));
    {
#pragma unroll
    for (int a = 0; a < 2; ++a)
#pragma unroll
        for (int b = 0; b < 2; ++b)
#pragma unroll
            for (int m = 0; m < 4; ++m)
#pragma unroll
                for (int n = 0; n < 2; ++n) acc[a][b][m][n] = (f32x4){0.f, 0.f, 0.f, 0.f};
    }
    bf16x8 At[4][2], B0[2][2], B1[2][2];
    const char* cA = (const char*)g.A + (size_t)cur.pm * tstep + cur.ko; const char* cB = (const char*)g.Bt + (size_t)cur.pb * tstep + cur.ko;
    S.a_ready(cur);
    if constexpr (SP2) {
        PG8_STAGE(PG8_SB(0, 0), cB, voffB); PG8_STAGE(PG8_SB(0, 1), cB + hstep, voffB); PG8_STAGE(PG8_SA(0, 0), cA, voffA); PG8_STAGE(PG8_SA(0, 1), cA + hstep, voffA);
        if (wr == 1) PG8_BAR;
        PG8_WAIT_V(2); PG8_BAR;
        PG8_STAGE(PG8_SB(1, 0), cB + kstep, voffB); PG8_STAGE(PG8_SA(1, 0), cA + kstep, voffA); PG8_STAGE(PG8_SB(1, 1), cB + hstep + kstep, voffB);
        PG8_WAIT_V(6); PG8_BAR;
    } else {
        PG8_STAGE(PG8_SB(0, 0), cB, voffB); PG8_STAGE(PG8_SA(0, 0), cA, voffA); PG8_STAGE(PG8_SB(0, 1), cB + hstep, voffB); PG8_STAGE(PG8_SA(0, 1), cA + hstep, voffA);
        if (wr == 1) PG8_BAR;
        PG8_WAIT_V(4); PG8_BAR;
        PG8_STAGE(PG8_SB(1, 0), cB + kstep, voffB); PG8_STAGE(PG8_SA(1, 0), cA + kstep, voffA); PG8_STAGE(PG8_SB(1, 1), cB + hstep + kstep, voffB);
        PG8_WAIT_V(6); PG8_BAR;
    }
    for (;;) {
        const bool has_next = S.next(ui + 1, nxt);
        const char* nA = has_next ? (const char*)g.A + (size_t)nxt.pm * tstep + nxt.ko : cA; const char* nB = has_next ? (const char*)g.Bt + (size_t)nxt.pb * tstep + nxt.ko : cB;
        for (int t = 0; t < nt; t += 2) { PG8_KBODY(false) }
        if constexpr (F8) asm volatile("s_nop 15\n\ts_nop 15" ::: "memory");
        if constexpr (ALIGN_EPI) { if (wr == 0) PG8_BAR; }
        if constexpr (!Epi::AFTER_DRAIN) { E(acc, cur, wr, wc, fr, fq); S.done(cur); }
        if (!has_next) break;
        {
#pragma unroll
    for (int a = 0; a < 2; ++a)
#pragma unroll
        for (int b = 0; b < 2; ++b)
#pragma unroll
            for (int m = 0; m < 4; ++m)
#pragma unroll
                for (int n = 0; n < 2; ++n) acc[a][b][m][n] = (f32x4){0.f, 0.f, 0.f, 0.f};
        }
        cur = nxt; cA = nA; cB = nB; ++ui;
        if constexpr (ALIGN_EPI) { if (wr == 1) PG8_BAR; }
    }
    PG8_WAIT_V(0);
    if constexpr (!ALIGN_EPI) { if (wr == 0) PG8_BAR; }
    PG8_BAR;
    if constexpr (Epi::AFTER_DRAIN) { E.fused(acc, cur, wr, wc, fr, fq, lds, wid, lane); S.done(cur); }
#undef PG8_SA
#undef PG8_SB
#undef PG8_STAGE
#undef PG8_LDA
#undef PG8_LDB
#undef PG8_MMA
#undef PG8_MMAZ
#undef PG8_KBODY
#undef PG8_WAIT_V
#undef PG8_WAIT_L
#undef PG8_BAR
#undef PG8_SCHED
}
}
#define XB_TMO      128
#define XB_XCNT(j)  (256  + 64 * (j))
#define XB_XSUB(j)  (1280 + 64 * (j))
#define XB_XGEN(j)  (2304 + 64 * (j))
#define XB_TOP      3328
#define XB_TOPGEN   3392
#define XCD_BAR_WORDS 3456
#define XB_SPIN_CAP (1u << 18)

__device__ __forceinline__ unsigned xb_ld(unsigned* p)              { return __hip_atomic_load(p, __ATOMIC_RELAXED, __HIP_MEMORY_SCOPE_AGENT); }
__device__ __forceinline__ unsigned xb_add(unsigned* p, unsigned v) { return __hip_atomic_fetch_add(p, v, __ATOMIC_RELAXED, __HIP_MEMORY_SCOPE_AGENT); }
__device__ __forceinline__ unsigned xb_xcc_id() { return (unsigned)__builtin_amdgcn_s_getreg((3 << 11) | 20) & 0xFu; }
#define XB_SPIN(cond, bar) do { unsigned _sp = 0; while (cond) { __builtin_amdgcn_s_sleep(1); \
    if ((++_sp & 255u) == 0u) { if (xb_ld(&(bar)[XB_TMO])) break; if (_sp > XB_SPIN_CAP) { atomicAdd(&(bar)[XB_TMO], 1u); break; } } } } while (0)

struct XcdBarrier {
    unsigned* bar; unsigned x; unsigned wave;
    volatile LAS unsigned* st;
};

__device__ __forceinline__ XcdBarrier xcd_barrier_post(unsigned* bar, volatile LAS unsigned* st) {
    XcdBarrier b; b.bar = bar; b.x = xb_xcc_id(); b.st = st;
    if (threadIdx.x == 0) (void)xb_add(&bar[XB_XCNT(b.x)], 1u);
    b.wave = (unsigned)__builtin_amdgcn_readfirstlane(threadIdx.x >> 6);
    return b;
}
__device__ __forceinline__ void xcd_barrier_complete(unsigned* bar, unsigned x, unsigned& nloc, unsigned& nx) {
    const unsigned G = gridDim.x * gridDim.y * gridDim.z;
    unsigned sum, cnt, mine, sp = 0u;
    for (;;) {
        sum = 0u; cnt = 0u; mine = 0u;
#pragma unroll
        for (unsigned j = 0; j < 16; ++j) { const unsigned c = xb_ld(&bar[XB_XCNT(j)]); sum += c; cnt += (c > 0u) ? 1u : 0u; mine = (j == x) ? c : mine; }
        if (sum == G) break;
        __builtin_amdgcn_s_sleep(1);
        if ((++sp & 255u) == 0u) { if (xb_ld(&bar[XB_TMO])) break; if (sp > XB_SPIN_CAP) { atomicAdd(&bar[XB_TMO], 1u); break; } }
    }
    nloc = mine > 0u ? mine : 1u; nx = cnt > 0u ? cnt : 1u;
}

__device__ __forceinline__ void xcd_barrier(const XcdBarrier& b) {
    asm volatile("s_waitcnt vmcnt(0)" ::: "memory");
    __syncthreads();
    unsigned bl_; asm volatile("v_mbcnt_lo_u32_b32 %0, -1, 0\n\tv_mbcnt_hi_u32_b32 %0, -1, %0" : "=v"(bl_));
    if (b.wave == 0u && bl_ == 0u) {
        unsigned* bar = b.bar;
        __builtin_amdgcn_s_waitcnt(0);
        unsigned nloc = b.st[0], nx = b.st[1];
        if (nloc == 0u) { xcd_barrier_complete(bar, b.x, nloc, nx); b.st[0] = nloc; b.st[1] = nx; }
        const unsigned old = xb_add(&bar[XB_XSUB(b.x)], 1u);
        const unsigned gen = old / nloc;
        if (old + 1u == (gen + 1u) * nloc) {
            __builtin_amdgcn_fence(__ATOMIC_RELEASE, "agent");
            asm volatile("s_waitcnt vmcnt(0)" ::: "memory");
            const unsigned og = xb_add(&bar[XB_TOP], 1u);
            const unsigned tg = og / nx;
            if (og + 1u == (tg + 1u) * nx) xb_add(&bar[XB_TOPGEN], 1u);
            else XB_SPIN(xb_ld(&bar[XB_TOPGEN]) == tg, bar);
            __builtin_amdgcn_fence(__ATOMIC_ACQUIRE, "agent");
            xb_add(&bar[XB_XGEN(b.x)], 1u);
            asm volatile("s_waitcnt vmcnt(0)" ::: "memory");
        } else {
            XB_SPIN(xb_ld(&bar[XB_XGEN(b.x)]) == gen, bar);
            __builtin_amdgcn_fence(__ATOMIC_ACQUIRE, "agent");
            asm volatile("s_waitcnt vmcnt(0)" ::: "memory");
        }
    }
    __syncthreads();
}

struct Frame {
    LAS unsigned char* lds;
    volatile LAS unsigned* MISC;
    unsigned* ctl;
    int tid, lane, wave, G;
    float* out; unsigned char* ws;
};
#define WSP(T, off) ((T*)(F.ws + (off)))
#if defined(__HIP_DEVICE_COMPILE__)
typedef __attribute__((address_space(4))) const char* kargp_t;
__device__ __forceinline__ kargp_t karg_base() { kargp_t p = (kargp_t)__builtin_amdgcn_kernarg_segment_ptr(); asm volatile("" : "+s"(p)); return p; }
#define KIN(i) (((__attribute__((address_space(4))) const float* const*)karg_base())[i])
#else
#define KIN(i) ((const float*)nullptr)
#endif

struct TrItem { const float* src; int ldsrc; int valid; unsigned char* dst; int dstKb; int kind; float scale; };
__device__ __forceinline__ int gate_up_row(int n0) { return (n0 >> 7) * 256 + (n0 & 127); }
__device__ __forceinline__ void tr_load(const TrItem& t, f32x4 (&v)[8], int lane) {
#pragma unroll
    for (int i = 0; i < 8; ++i) { const int kk = 8 * i + (lane >> 3); v[i] = t.valid ? *(const f32x4*)(t.src + (size_t)kk * t.ldsrc + 4 * (lane & 7)) : (f32x4){0.f, 0.f, 0.f, 0.f}; }
}
__device__ __forceinline__ void tr_store(const TrItem& t, const f32x4 (&v)[8], LAS float* scr, int lane) {
    if (t.kind == 0) {
#pragma unroll
        for (int i = 0; i < 8; ++i) { const int kk = 8 * i + (lane >> 3); *(LAS f32x4*)(scr + kk * 32 + ((4 * (lane & 7)) ^ (((kk >> 3) << 2) & 31))) = v[i]; }
        LDS_WAIT(); asm volatile("" ::: "memory");
        const int c = lane & 7;
#pragma unroll
        for (int j = 0; j < 4; ++j) { const int n = (lane >> 3) + 8 * j; const LAS float* s = scr + (8 * c) * 32 + (n ^ ((c << 2) & 31));
            v4u o; o.x = pk2(s[0 * 32], s[1 * 32]); o.y = pk2(s[2 * 32], s[3 * 32]); o.z = pk2(s[4 * 32], s[5 * 32]); o.w = pk2(s[6 * 32], s[7 * 32]);
            *(GAS v4u*)(t.dst + (size_t)n * t.dstKb + 16 * c) = o; }
    } else {
#pragma unroll
        for (int i = 0; i < 8; ++i) { const int kk = 8 * i + (lane >> 3); *(LAS f32x4*)(scr + kk * 32 + ((4 * (lane & 7)) ^ (((kk >> 4) & 3) << 3))) = v[i] * t.scale; }
        LDS_WAIT(); asm volatile("" ::: "memory");
        const int c = lane & 3;
#pragma unroll
        for (int j = 0; j < 2; ++j) { const int n = (lane >> 2) + 16 * j; const LAS float* s = scr + (16 * c) * 32 + (n ^ (c << 3));
            v4u o; o.x = pk4_fp8(s[0 * 32], s[1 * 32], s[2 * 32], s[3 * 32]); o.y = pk4_fp8(s[4 * 32], s[5 * 32], s[6 * 32], s[7 * 32]);
            o.z = pk4_fp8(s[8 * 32], s[9 * 32], s[10 * 32], s[11 * 32]); o.w = pk4_fp8(s[12 * 32], s[13 * 32], s[14 * 32], s[15 * 32]);
            *(GAS v4u*)(t.dst + (size_t)n * t.dstKb + 16 * c) = o; }
    }
    LDS_WAIT(); asm volatile("" ::: "memory");
}
constexpr int TI_E1 = 8 * 32 * 224, TI_E2 = 8 * 112 * 64, TI_IN = 32 * 176, TI_O = 32 * 64, TI_F1 = 32 * 176, TI_F2 = 88 * 64, TI_QKV = 32 * 192;
constexpr int TI_N = 2 * TI_E1 + TI_E2 + TI_IN + 2 * TI_O + 2 * TI_F1 + TI_F2 + TI_QKV;
__device__ __forceinline__ TrItem tr_decode(Frame& F, int r) {
    TrItem t; t.valid = 1; t.kind = 0; t.scale = 1.f;
    if (r < 2 * TI_E1) { const int w3 = r >= TI_E1; if (w3) r -= TI_E1; const int e = r / (32 * 224), rr = r % (32 * 224), kb = 2 * (rr / 448) + (rr & 1), n0 = 32 * ((rr % 448) >> 1);
        t.src = (w3 ? KIN(42) : KIN(41)) + ((size_t)e * 2048 + 64 * kb) * 7168 + n0; t.ldsrc = 7168; t.kind = 1; t.scale = SC_W13;
        t.dst = WSP(unsigned char, W_E13) + ((size_t)e * 14336 + gate_up_row(n0) + 128 * w3) * 2048 + 64 * kb; t.dstKb = 2048; return t; } r -= 2 * TI_E1;
    if (r < TI_E2) { const int e = r / (112 * 64), rr = r % (112 * 64), kb = 2 * (rr / 128) + (rr & 1), n0 = 32 * ((rr % 128) >> 1);
        t.src = KIN(43) + ((size_t)e * 7168 + 64 * kb) * 2048 + n0; t.ldsrc = 2048; t.kind = 1; t.scale = SC_W2;
        t.dst = WSP(unsigned char, W_E2) + ((size_t)e * 2048 + n0) * 7168 + 64 * kb; t.dstKb = 7168; return t; } r -= TI_E2;
    if (r < TI_IN) { const int kb = r / 176, n0 = 32 * (r % 176);
        t.src = KIN(8) + (size_t)(64 * kb) * NIN + n0; t.ldsrc = NIN; t.valid = n0 < NIN;
#ifdef IN_F8
        t.kind = 1; t.scale = SC_W13; t.dst = WSP(unsigned char, W_WIN) + (size_t)n0 * 2048 + 64 * kb; t.dstKb = 2048; return t; } r -= TI_IN;
#else
        t.dst = WSP(unsigned char, W_WIN) + ((size_t)n0 * 2048 + 64 * kb) * 2; t.dstKb = 4096; return t; } r -= TI_IN;
#endif
    if (r < TI_O) { const int kb = r / 64, n0 = 32 * (r % 64);
        t.src = KIN(23) + (size_t)(64 * kb) * 2048 + n0; t.ldsrc = 2048;
#ifdef WO0_F8
        t.kind = 1; t.scale = SC_W13; t.dst = WSP(unsigned char, W_WO0) + (size_t)n0 * 4096 + 64 * kb; t.dstKb = 4096; return t; } r -= TI_O;
#else
        t.dst = WSP(unsigned char, W_WO0) + ((size_t)n0 * 2048 + 64 * kb) * 2; t.dstKb = 4096; return t; } r -= TI_O;
#endif
    if (r < 2 * TI_F1) { const int w3 = r >= TI_F1; if (w3) r -= TI_F1; const int kb = r / 176, n0 = 32 * (r % 176);
        t.src = (w3 ? KIN(25) : KIN(24)) + (size_t)(64 * kb) * FF + n0; t.ldsrc = FF;
#ifdef F13_F8
        t.kind = 1; t.scale = SC_W13; t.dst = WSP(unsigned char, W_W13) + (size_t)(gate_up_row(n0) + 128 * w3) * 2048 + 64 * kb; t.dstKb = 2048; return t; } r -= 2 * TI_F1;
#else
        t.dst = WSP(unsigned char, W_W13) + ((size_t)(gate_up_row(n0) + 128 * w3) * 2048 + 64 * kb) * 2; t.dstKb = 4096; return t; } r -= 2 * TI_F1;
#endif
    if (r < TI_F2) { const int kb = r / 64, n0 = 32 * (r % 64);
        t.src = KIN(26) + (size_t)(64 * kb) * 2048 + n0; t.ldsrc = 2048;
#ifdef F2_BF16
        t.dst = WSP(unsigned char, W_W2) + ((size_t)n0 * FF + 64 * kb) * 2; t.dstKb = 2 * FF; return t; } r -= TI_F2;
#else
        t.kind = 1; t.scale = SC_W2; t.dst = WSP(unsigned char, W_W2) + (size_t)n0 * FF + 64 * kb; t.dstKb = FF; return t; } r -= TI_F2;
#endif
    if (r < TI_QKV) { const int kb = r / 192, n0 = 32 * (r % 192);
        t.src = KIN(31) + (size_t)(64 * kb) * 6144 + n0; t.ldsrc = 6144;
#ifdef QKV_F8
        t.kind = 1; t.scale = SC_W13; t.dst = WSP(unsigned char, W_QKV) + (size_t)n0 * 2048 + 64 * kb; t.dstKb = 2048; return t; } r -= TI_QKV;
#else
        t.dst = WSP(unsigned char, W_QKV) + ((size_t)n0 * 2048 + 64 * kb) * 2; t.dstKb = 4096; return t; } r -= TI_QKV;
#endif
    { const int kb = r / 64, n0 = 32 * (r % 64);
        t.src = KIN(39) + (size_t)(64 * kb) * 2048 + n0; t.ldsrc = 2048;
#ifdef WO1_F8
        t.kind = 1; t.scale = SC_W13; t.dst = WSP(unsigned char, W_WO1) + (size_t)n0 * 2048 + 64 * kb; t.dstKb = 2048; return t; }
#else
        t.dst = WSP(unsigned char, W_WO1) + ((size_t)n0 * 2048 + 64 * kb) * 2; t.dstKb = 4096; return t; }
#endif
}
constexpr int TI_NQ = 2 * TI_E1 + TI_E2;
__device__ __forceinline__ void convert_items(Frame& F, int first, int count, LAS float* scr) {
    TrItem cur = tr_decode(F, first); f32x4 vc[8]; tr_load(cur, vc, F.lane);
#pragma unroll 1
    for (int i = 0; i < count; ++i) {
        const bool more = i + 1 < count;
        TrItem nxt = cur; f32x4 vn[8];
        if (more) { nxt = tr_decode(F, first + i + 1); tr_load(nxt, vn, F.lane); }
        tr_store(cur, vc, scr, F.lane);
        if (more) {
#pragma unroll
            for (int j = 0; j < 8; ++j) vc[j] = vn[j];
            cur = nxt; }
    }
}
__device__ __forceinline__ void convert_queue(Frame& F, int done_slot, unsigned need) {
#ifndef QGRAB
#define QGRAB 2
#endif
    constexpr int SH = TI_NQ / 8, GRAB = QGRAB; static_assert(TI_NQ % 8 == 0 && SH % GRAB == 0, "queue shards");
    const int shard = blockIdx.x & 7;
    for (;;) {
        unsigned q = 0;
        if (F.lane == 0) q = __hip_atomic_fetch_add(F.ctl + CW_CQ + 64 * shard, (unsigned)GRAB, __ATOMIC_RELAXED, __HIP_MEMORY_SCOPE_AGENT);
        q = (unsigned)__builtin_amdgcn_readfirstlane((int)q);
        if (q >= (unsigned)SH) break;
        convert_items(F, shard * SH + (int)q, min(GRAB, SH - (int)q), (LAS float*)(F.lds + F.wave * 8192));
        if (need) { unsigned d = 0; if (F.lane == 0) d = __hip_atomic_load(F.ctl + CW_DONE + 64 * done_slot, __ATOMIC_RELAXED, __HIP_MEMORY_SCOPE_AGENT); d = (unsigned)__builtin_amdgcn_readfirstlane((int)d); if (d >= need) break; }
    }
}
__device__ __forceinline__ void convert_grab(Frame& F, LAS float* scr) {
    constexpr int SH = TI_NQ / 8, GRAB = 2;
    const int shard = blockIdx.x & 7;
    unsigned q = 0;
    if (F.lane == 0) q = __hip_atomic_fetch_add(F.ctl + CW_CQ + 64 * shard, (unsigned)GRAB, __ATOMIC_RELAXED, __HIP_MEMORY_SCOPE_AGENT);
    q = (unsigned)__builtin_amdgcn_readfirstlane((int)q);
    if (q < (unsigned)SH) {
#pragma unroll 1
        for (int i = 0; i < GRAB; ++i) { const TrItem t = tr_decode(F, shard * SH + (int)q + i); f32x4 v[8]; tr_load(t, v, F.lane); __builtin_amdgcn_s_waitcnt(0x0F70); tr_store(t, v, scr, F.lane); } }
}
__device__ __forceinline__ void fill_tail(Frame& F, int done_slot, int nwg) {
    const int R = nwg % F.G; if (R == 0) return;
    if ((int)blockIdx.x < R) { if (F.tid == 0) __hip_atomic_fetch_add(F.ctl + CW_DONE + 64 * done_slot, 1u, __ATOMIC_RELAXED, __HIP_MEMORY_SCOPE_AGENT); }
    else if (F.wave < 4) convert_queue(F, done_slot, (unsigned)R);
}
__device__ __forceinline__ void p0_transposes(Frame& F) {
    LAS float* scr = (LAS float*)(F.lds + F.wave * 8192);
    const int gw = blockIdx.x * NWAVES + F.wave, NGW = F.G * NWAVES;
    int it = TI_NQ + gw;
    if (it < TI_N) {
        TrItem cur = tr_decode(F, it); f32x4 vc[8]; tr_load(cur, vc, F.lane);
#pragma unroll 1
        for (;;) {
            const int nx = it + NGW; const bool more = nx < TI_N;
            TrItem nxt = cur; f32x4 vn[8];
            if (more) { nxt = tr_decode(F, nx); tr_load(nxt, vn, F.lane); }
            tr_store(cur, vc, scr, F.lane);
            if (!more) break;
#pragma unroll
            for (int i = 0; i < 8; ++i) vc[i] = vn[i];
            cur = nxt; it = nx;
        }
    }
    bf16* WUPT = WSP(bf16, WS_SMALLW); bf16* AUPT = WUPT + 2 * 1024 * 64; bf16* GUPT = AUPT + 2 * 1024 * 64;
    const int gt = blockIdx.x * 512 + F.tid, NGT = F.G * 512;
    for (int i = gt; i < 2 * 65536; i += NGT) { const int d = i >> 16, n = (i >> 6) & 1023, k = i & 63;
        WUPT[i] = (bf16)f2bf(KIN(14)[(size_t)d * 65536 + k * 1024 + n]); AUPT[i] = (bf16)f2bf(KIN(16)[(size_t)d * 65536 + k * 1024 + n]); }
    for (int i = gt; i < 1024 * 160; i += NGT) { const int n = i / 160, k = i % 160; GUPT[i] = (bf16)f2bf(KIN(17)[(size_t)k * 1024 + n]); }
}
__device__ __forceinline__ void p0_ada(Frame& F) {
    LAS float* tab = (LAS float*)F.lds;
    LAS float* red = (LAS float*)(F.lds + 80 * 1024);
    for (int i = F.tid; i < 9 * 2048; i += 512) { const int m = i >> 11, k = i & 2047; const float c = m < 8 ? KIN(1)[m * 2048 + k] : KIN(3)[k]; tab[i] = c / (1.0f + expf(-c)); }
    __syncthreads();
    float* MOD = WSP(float, WS_MOD);
    const int q = F.tid & 7, kl = F.tid >> 3;
    for (int u = blockIdx.x; u < 768; u += F.G) {
        const int layer = u / 384, col0 = (u % 384) * 32;
        const float* W = layer ? KIN(27) : KIN(4); const float* bias = layer ? KIN(28) : KIN(5);
        float acc[9][4];
#pragma unroll
        for (int m = 0; m < 9; ++m)
#pragma unroll
            for (int j = 0; j < 4; ++j) acc[m][j] = 0.f;
#pragma unroll 8
        for (int i = 0; i < 32; ++i) { const int k = kl + 64 * i; const f32x4 w = *(const f32x4*)(W + (size_t)k * 12288 + col0 + 4 * q);
#pragma unroll
            for (int m = 0; m < 9; ++m) { const float s = tab[m * 2048 + k];
#pragma unroll
                for (int j = 0; j < 4; ++j) acc[m][j] += s * w[j]; } }
#pragma unroll
        for (int m = 0; m < 9; ++m)
#pragma unroll
            for (int j = 0; j < 4; ++j) { float v = acc[m][j]; v += __shfl_xor(v, 8); v += __shfl_xor(v, 16); v += __shfl_xor(v, 32); if (F.lane < 8) red[(F.wave * 8 + q) * 36 + m * 4 + j] = v; }
        __syncthreads();
        if (F.tid < 288) { const int m = F.tid >> 5, c = F.tid & 31, qq = c >> 2, j = c & 3; float s = 0.f;
#pragma unroll
            for (int w = 0; w < 8; ++w) s += red[(w * 8 + qq) * 36 + m * 4 + j];
            MOD[((size_t)layer * 9 + m) * 12288 + col0 + c] = s + bias[col0 + c]; }
        __syncthreads();
    }
}
template <bool FP8OUT = false>
__device__ __forceinline__ void norm_mod_rows(Frame& F, const float* xl, const float* xc, const float* g, const float* modl, int s_shift, int s_scale, bf16* out, int nrows) {
    const int gw = blockIdx.x * NWAVES + F.wave, NGW = F.G * NWAVES;
    const int per = (nrows + NGW - 1) / NGW, r0 = gw * per, r1 = min(nrows, r0 + per);
    if (r0 >= r1) return;
    f32x4 gm[8], hm[8];
#define NM_SRC(r) ((const f32x4*)((r) < RL ? xl + (size_t)(r) * D : xc + (size_t)((r) - RL) * D))
#define NM_LOAD(v, r) do { const f32x4* s_ = NM_SRC(r); _Pragma("unroll") for (int j = 0; j < 8; ++j) v[j] = s_[F.lane + 64 * j]; asm volatile("" ::: "memory"); __builtin_amdgcn_sched_barrier(0); } while (0)
#define NM_ROW(v, r) do { float ss = 0.f;                                                                                                                    \
        _Pragma("unroll") for (int j = 0; j < 8; ++j) ss += (v[j].x * v[j].x + v[j].y * v[j].y) + (v[j].z * v[j].z + v[j].w * v[j].w);                        \
        const float rstd = 1.0f / sqrtf(wave_sum(ss) * (1.0f / D) + 1e-6f);                                                                                  \
        v2u* o8 = (v2u*)(out + (size_t)(r) * D); unsigned* o4 = (unsigned*)((unsigned char*)out + (size_t)(r) * D);                                          \
        _Pragma("unroll") for (int j = 0; j < 8; ++j) { const f32x4 y = v[j] * rstd * gm[j] + hm[j];                                                          \
            if (FP8OUT) o4[F.lane + 64 * j] = pk4_fp8(y.x * SC_A8, y.y * SC_A8, y.z * SC_A8, y.w * SC_A8);                                                   \
            else { v2u w; w.x = pk2(y.x, y.y); w.y = pk2(y.z, y.w); o8[F.lane + 64 * j] = w; } }                                                             \
        asm volatile("" ::: "memory"); __builtin_amdgcn_sched_barrier(0); } while (0)
    for (int s0 = r0; s0 < r1;) {
        const int mrow = s0 < RL ? (s0 >> 11) : 8, send = min(r1, mrow < 8 ? (mrow + 1) << 11 : nrows);
        { const f32x4* sh = (const f32x4*)(modl + (size_t)mrow * 12288 + s_shift * 2048); const f32x4* sc = (const f32x4*)(modl + (size_t)mrow * 12288 + s_scale * 2048);
#pragma unroll
          for (int j = 0; j < 8; ++j) { const int c4 = F.lane + 64 * j; gm[j] = ((const f32x4*)g)[c4] * (sc[c4] + 1.0f); hm[j] = sh[c4]; } }
        __builtin_amdgcn_s_waitcnt(0x0F70);
        f32x4 va[8], vb[8];
        NM_LOAD(va, s0);
        __builtin_amdgcn_s_waitcnt(0x0F70);
#pragma unroll 1
        for (int r = s0; r < send; r += 2) {
            __builtin_amdgcn_s_waitcnt(0x0F78);
            if (r + 1 < send) NM_LOAD(vb, r + 1);
            NM_ROW(va, r);
            if (r + 1 < send) { __builtin_amdgcn_s_waitcnt(0x0F78); if (r + 2 < send) NM_LOAD(va, r + 2); NM_ROW(vb, r + 1); }
        }
        __builtin_amdgcn_s_waitcnt(0x0F70);
        s0 = send;
    }
#undef NM_SRC
#undef NM_LOAD
#undef NM_ROW
}
__device__ __forceinline__ void copy_rows(Frame& F, const float* src, float* dst, size_t n4) {
    const size_t gt = (size_t)blockIdx.x * 512 + F.tid, NGT = (size_t)F.G * 512;
#ifdef PROBE_ST8
    for (size_t i = gt; i < n4; i += NGT) { const f32x4 v = ((const f32x4*)src)[i]; const size_t w_ = i >> 6, l_ = i & 63; v2u* d = (v2u*)((f32x4*)dst + w_ * 64);
        d[l_] = (v2u){__builtin_bit_cast(unsigned, v.x), __builtin_bit_cast(unsigned, v.y)}; d[64 + l_] = (v2u){__builtin_bit_cast(unsigned, v.z), __builtin_bit_cast(unsigned, v.w)}; }
#else
    for (size_t i = gt; i < n4; i += NGT) ((f32x4*)dst)[i] = ((const f32x4*)src)[i];
#endif
}

constexpr size_t FE_R = 0, FE_KK = 1, FE_V = 2, FE_K = 3, FE_E0 = 4, FE_A0 = 5;
constexpr size_t WS_YD = WS_ACTC + 9 * FEAT_SZ;
static_assert(WS_YD + (size_t)2 * RT * 1024 * 4 <= WS_ACTC + 476 * MiB, "YD fits");
#define FEAT(i) ((bf16*)(F.ws + WS_ACTC + (size_t)(i) * FEAT_SZ))

__device__ __forceinline__ void unpack8(const v4u& w, float (&f)[8]) {
    f[0] = bflo(w.x); f[1] = bfhi(w.x); f[2] = bflo(w.y); f[3] = bfhi(w.y); f[4] = bflo(w.z); f[5] = bfhi(w.z); f[6] = bflo(w.w); f[7] = bfhi(w.w);
}
__device__ __forceinline__ v4u pack8(const float (&f)[8]) { v4u w; w.x = pk2(f[0], f[1]); w.y = pk2(f[2], f[3]); w.z = pk2(f[4], f[5]); w.w = pk2(f[6], f[7]); return w; }

__device__ __forceinline__ void sgu_unit(Frame& F, int u, const bf16* HL, bf16* AB) {
    constexpr int LQ = 136;
    LAS bf16* vt = (LAS bf16*)F.lds;
    const int chunk = u >> 3, g = u & 7, row0 = chunk * 128;
    {
        const int q = F.tid >> 2, part = F.tid & 3;
        const bf16* vp = HL + (size_t)(row0 + q) * NINP + 1024 + g * 128 + part * 32;
        float x[32]; float ss = 0.f;
#pragma unroll
        for (int k = 0; k < 4; ++k) { const v4u w = *(const v4u*)(vp + 8 * k); float f[8]; unpack8(w, f);
#pragma unroll
            for (int e = 0; e < 8; ++e) { x[8 * k + e] = f[e]; ss += f[e] * f[e]; } }
        ss += __shfl_xor(ss, 1); ss += __shfl_xor(ss, 2);
        const float rstd = 1.0f / sqrtf(ss * (1.0f / 128.0f) + 1e-6f);
        const float* ng = KIN(9) + g * 128 + part * 32;
#pragma unroll
        for (int e = 0; e < 32; ++e) vt[(part * 32 + e) * LQ + q] = (bf16)f2bf(x[e] * rstd * ng[e]);
    }
    __syncthreads();
    {
        const int l15 = F.lane & 15, lq = F.lane >> 4, p = 16 * F.wave + l15;
        const float* wrow = KIN(10) + ((size_t)g * 128 + p) * 128;
        bf16x8 wfr[4];
#pragma unroll
        for (int ks = 0; ks < 4; ++ks) { const f32x4 a = *(const f32x4*)(wrow + 32 * ks + 8 * lq), b = *(const f32x4*)(wrow + 32 * ks + 8 * lq + 4);
            v4u w; w.x = pk2(a.x, a.y); w.y = pk2(a.z, a.w); w.z = pk2(b.x, b.y); w.w = pk2(b.z, b.w); wfr[ks] = __builtin_bit_cast(bf16x8, w); }
        const float bsp = KIN(11)[g * 128 + p];
        const bf16* urow = HL + (size_t)(row0 + p) * NINP + g * 128; bf16* orow = AB + (size_t)(row0 + p) * D + g * 128;
#pragma unroll
        for (int ct = 0; ct < 8; ++ct) {
            f32x4 acc = {0.f, 0.f, 0.f, 0.f};
#pragma unroll
            for (int ks = 0; ks < 4; ++ks) { const bf16x8 vf = *(const LAS bf16x8*)(vt + (16 * ct + l15) * LQ + 32 * ks + 8 * lq);
                acc = __builtin_amdgcn_mfma_f32_16x16x32_bf16(vf, wfr[ks], acc, 0, 0, 0); }
            const int c = 16 * ct + 4 * lq; const v2u uw = *(const v2u*)(urow + c);
#ifdef WO0_F8
            *(unsigned*)((unsigned char*)AB + (size_t)(row0 + p) * (2 * D) + g * 128 + c) = pk4_fp8(SC_A8 * bflo(uw.x) * (acc[0] + bsp), SC_A8 * bfhi(uw.x) * (acc[1] + bsp), SC_A8 * bflo(uw.y) * (acc[2] + bsp), SC_A8 * bfhi(uw.y) * (acc[3] + bsp));
            (void)orow;
#else
            v2u o; o.x = pk2(bflo(uw.x) * (acc[0] + bsp), bfhi(uw.x) * (acc[1] + bsp)); o.y = pk2(bflo(uw.y) * (acc[2] + bsp), bfhi(uw.y) * (acc[3] + bsp));
            *(v2u*)(orow + c) = o;
#endif
        }
    }
    __syncthreads();
}

constexpr int FT = 32, FNR = FT / 8;
__device__ __forceinline__ void feat_unit(Frame& F, int u, const bf16* HL, bf16* AB) {
    constexpr int LT = 72, LG = 168;
    LAS bf16* TW = (LAS bf16*)F.lds; LAS bf16* AD = TW + 64 * LT; LAS bf16* SG = AD + 64 * LT;
    const int row0 = u * FT; const bool lat = row0 < RL; const int seqlen = lat ? SEQ : CTX; const int p0 = (lat ? row0 : row0 - RL) & (seqlen - 1);
    bf16* Rr = FEAT(FE_R); bf16* KKr = FEAT(FE_KK); bf16* Vr = FEAT(FE_V); bf16* Kt = FEAT(FE_K);
    {
        const int lr0 = FNR * F.wave;
        const float* const kkbase = KIN(18);
        v4u zn[FNR + 2]; f32x4 wn[6];
        const float* const swp = KIN(12);
#define F1_LOADZ(ii, dst) do { const bool act_ = ((ii) < 6) || (F.lane < 36); const int ci_ = act_ ? ((ii) < 6 ? F.lane + 64 * (ii) : 384 + F.lane) : 0; \
            _Pragma("unroll") for (int jj = 0; jj < FNR + 2; ++jj) { const int pos = p0 + lr0 - 1 + jj; const bool ok = pos >= 0 && pos < seqlen; \
                dst[jj] = ok ? *(const v4u*)(HL + (size_t)(row0 + lr0 - 1 + jj) * NINP + ZB + 8 * ci_) : (v4u){0u, 0u, 0u, 0u}; } \
            { const float* sw_ = swp + 8 * ci_; wn[0] = *(const f32x4*)sw_; wn[1] = *(const f32x4*)(sw_ + 4); wn[2] = *(const f32x4*)(sw_ + 3360); wn[3] = *(const f32x4*)(sw_ + 3364); wn[4] = *(const f32x4*)(sw_ + 6720); wn[5] = *(const f32x4*)(sw_ + 6724); } } while (0)
        F1_LOADZ(0, zn);
#pragma unroll 1
        for (int i = 0; i < 7; ++i) {
            const bool active = (i < 6) || (F.lane < 36);
            const int ci = active ? (i < 6 ? F.lane + 64 * i : 384 + F.lane) : 0, col = 8 * ci;
            float w0[8], w1[8], w2[8];
            { const f32x4 a = wn[0], b = wn[1], c = wn[2], d = wn[3], e = wn[4], f = wn[5];
              w0[0] = a.x; w0[1] = a.y; w0[2] = a.z; w0[3] = a.w; w0[4] = b.x; w0[5] = b.y; w0[6] = b.z; w0[7] = b.w;
              w1[0] = c.x; w1[1] = c.y; w1[2] = c.z; w1[3] = c.w; w1[4] = d.x; w1[5] = d.y; w1[6] = d.z; w1[7] = d.w;
              w2[0] = e.x; w2[1] = e.y; w2[2] = e.z; w2[3] = e.w; w2[4] = f.x; w2[5] = f.y; w2[6] = f.z; w2[7] = f.w; }
            v4u z[FNR + 2];
#pragma unroll
            for (int jj = 0; jj < FNR + 2; ++jj) z[jj] = zn[jj];
            if (i + 1 < 7) F1_LOADZ(i + 1, zn);
#pragma unroll
            for (int j = 0; j < FNR; ++j) {
                float za[8], zb[8], zc[8], zs[8]; unpack8(z[j], za); unpack8(z[j + 1], zb); unpack8(z[j + 2], zc);
#pragma unroll
                for (int e = 0; e < 8; ++e) zs[e] = w0[e] * za[e] + w1[e] * zb[e] + w2[e] * zc[e];
                const int tok = lr0 + j; const size_t row = (size_t)(row0 + tok);
                if (i < 2) { *(v4u*)(Rr + row * 1024 + col) = pack8(zs); }
                else if (i < 4) { const int c1 = col - 1024; const float* kkp = kkbase + c1; float kr[8]; float ss = 0.f;
#pragma unroll
                    for (int e = 0; e < 8; ++e) { kr[e] = zs[e] * kkp[e]; ss += kr[e] * kr[e]; }
                    ss += __shfl_xor(ss, 1); ss += __shfl_xor(ss, 2); ss += __shfl_xor(ss, 4);
                    const float inv = 1.0f / fmaxf(sqrtf(ss), 1e-12f);
#pragma unroll
                    for (int e = 0; e < 8; ++e) kr[e] *= inv;
                    *(v4u*)(KKr + row * 1024 + c1) = pack8(kr); *(v4u*)(Kt + row * 1024 + c1) = pack8(zs); }
                else if (i < 6) { *(v4u*)(Vr + row * 1024 + (col - 2048)) = pack8(zs); }
                else if (active) {
                    if (F.lane < 8) { float t[8];
#pragma unroll
                        for (int e = 0; e < 8; ++e) t[e] = 2.0f * fast_sigmoid(2.0f * zs[e]) - 1.0f;
                        *(LAS v4u*)(TW + tok * LT + 8 * F.lane) = pack8(t); }
                    else if (F.lane < 16) { *(LAS v4u*)(AD + tok * LT + 8 * (F.lane - 8)) = pack8(zs); }
                    else { float t[8];
#pragma unroll
                        for (int e = 0; e < 8; ++e) t[e] = fast_sigmoid(zs[e]);
                        *(LAS v4u*)(SG + tok * LG + 8 * (F.lane - 16)) = pack8(t); }
                }
            }
        }
    }
    __syncthreads();
    {
        constexpr int ORS = 272, OAS = 64 * ORS;
        LAS unsigned char* OUT = F.lds + 40 * 1024;
        const int l15 = F.lane & 15, lq = F.lane >> 4;
        const bf16* WUPT = WSP(bf16, WS_SMALLW); const bf16* AUPT = WUPT + 2 * 1024 * 64; const bf16* GUPT = AUPT + 2 * 1024 * 64;
        const float* const pw0 = KIN(13); const float* const pa0 = KIN(15);
        {
            bf16x8 gn[5];
#define F2_LOADG(p_) do { const int nl_ = 128 * (p_) + 16 * F.wave + l15; _Pragma("unroll") for (int ks = 0; ks < 5; ++ks) gn[ks] = *(const bf16x8*)(GUPT + (size_t)nl_ * 160 + 32 * ks + 8 * lq); } while (0)
            F2_LOADG(0);
#pragma unroll 1
            for (int p = 0; p < 8; ++p) {
                bf16x8 fg[5];
#pragma unroll
                for (int ks = 0; ks < 5; ++ks) fg[ks] = gn[ks];
                if (p + 1 < 8) F2_LOADG(p + 1);
#pragma unroll
                for (int mt = 0; mt < FT / 16; ++mt) { const int tok = 16 * mt + l15; f32x4 ag = {0.f, 0.f, 0.f, 0.f};
#pragma unroll
                    for (int ks = 0; ks < 5; ++ks) { const bf16x8 xg = *(const LAS bf16x8*)(SG + tok * LG + 32 * ks + 8 * lq); ag = __builtin_amdgcn_mfma_f32_16x16x32_bf16(fg[ks], xg, ag, 0, 0, 0); }
                    v2u w_; w_.x = pk2(ag[0], ag[1]); w_.y = pk2(ag[2], ag[3]); *(LAS v2u*)(OUT + tok * ORS + (16 * F.wave + 4 * lq) * 2) = w_; }
                __syncthreads();
#pragma unroll
                for (int i = 0; i < FT / 32; ++i) { const int q = F.tid + 512 * i, row = q >> 4, c16 = q & 15;
                    *(v4u*)(AB + (size_t)(row0 + row) * D + 1024 + 128 * p + 8 * c16) = *(const LAS v4u*)(OUT + row * ORS + c16 * 16); }
                __syncthreads();
            }
#undef F2_LOADG
        }
        struct F2L { bf16x8 fw[2][2], fa[2][2]; f32x4 cw0, cw1, ca0, ca1; };
#define F2_LOAD(L, p_) do { const int n0_ = 128 * (p_) + 16 * F.wave, nl_ = n0_ + l15, nn_ = n0_ + 4 * lq; \
            _Pragma("unroll") for (int d = 0; d < 2; ++d) _Pragma("unroll") for (int ks = 0; ks < 2; ++ks) { L.fw[d][ks] = *(const bf16x8*)(WUPT + ((size_t)d * 1024 + nl_) * 64 + 32 * ks + 8 * lq); L.fa[d][ks] = *(const bf16x8*)(AUPT + ((size_t)d * 1024 + nl_) * 64 + 32 * ks + 8 * lq); } \
            L.cw0 = *(const f32x4*)(pw0 + nn_); L.cw1 = *(const f32x4*)(pw0 + 1024 + nn_); L.ca0 = *(const f32x4*)(pa0 + nn_); L.ca1 = *(const f32x4*)(pa0 + 1024 + nn_); } while (0)
        F2L nx; F2_LOAD(nx, 0);
#pragma unroll 1
        for (int p = 0; p < 8; ++p) {
            const F2L cu = nx;
            if (p + 1 < 8) F2_LOAD(nx, p + 1);
#pragma unroll 1
            for (int mt = 0; mt < FT / 16; ++mt) {
                const int tok = 16 * mt + l15;
                f32x4 aw0 = cu.cw0, aw1 = cu.cw1, aa0 = cu.ca0, aa1 = cu.ca1;
#pragma unroll
                for (int ks = 0; ks < 2; ++ks) { const bf16x8 xt = *(const LAS bf16x8*)(TW + tok * LT + 32 * ks + 8 * lq), xa = *(const LAS bf16x8*)(AD + tok * LT + 32 * ks + 8 * lq);
                    aw0 = __builtin_amdgcn_mfma_f32_16x16x32_bf16(cu.fw[0][ks], xt, aw0, 0, 0, 0); aw1 = __builtin_amdgcn_mfma_f32_16x16x32_bf16(cu.fw[1][ks], xt, aw1, 0, 0, 0);
                    aa0 = __builtin_amdgcn_mfma_f32_16x16x32_bf16(cu.fa[0][ks], xa, aa0, 0, 0, 0); aa1 = __builtin_amdgcn_mfma_f32_16x16x32_bf16(cu.fa[1][ks], xa, aa1, 0, 0, 0); }
                float e0[4], e1[4], a0[4], a1[4];
#pragma unroll
                for (int r = 0; r < 4; ++r) { e0[r] = 0.6065306597126334f * fast_sigmoid(aw0[r]); e1[r] = 0.6065306597126334f * fast_sigmoid(aw1[r]); a0[r] = fast_sigmoid(aa0[r]); a1[r] = fast_sigmoid(aa1[r]); }
                LAS unsigned char* op = OUT + tok * ORS + (16 * F.wave + 4 * lq) * 2;
#define STL(ai, VV) do { v2u w_; w_[0] = pk2(VV[0], VV[1]); w_[1] = pk2(VV[2], VV[3]); *(LAS v2u*)(op + (ai) * OAS) = w_; } while (0)
                STL(0, e0); STL(1, a0); STL(2, e1); STL(3, a1);
#undef STL
            }
            __syncthreads();
#pragma unroll
            for (int i = 0; i < FT / 32; ++i) { const int q = F.tid + 512 * i, row = q >> 4, c16 = q & 15; const size_t grow = (size_t)(row0 + row);
#pragma unroll
                for (int ai = 0; ai < 4; ++ai) *(v4u*)(FEAT(FE_E0 + ai) + grow * 1024 + 128 * p + 8 * c16) = *(const LAS v4u*)(OUT + ai * OAS + row * ORS + c16 * 16); }
            __syncthreads();
        }
#undef F2_LOAD
    }
}

template <int CTRL> __device__ __forceinline__ float dpp_add(float x) { return x + __builtin_bit_cast(float, __builtin_amdgcn_update_dpp(0, __builtin_bit_cast(int, x), CTRL, 0xf, 0xf, true)); }
__device__ __forceinline__ float red16(float x) { x = dpp_add<0xB1>(x); x = dpp_add<0x4E>(x); x = dpp_add<0x141>(x); x = dpp_add<0x140>(x); return x; }
__device__ __forceinline__ void red16x4(float& a, float& b, float& c, float& d) {
    asm volatile("s_nop 1\n\t"
        "v_add_f32_dpp %0, %0, %0 quad_perm:[1,0,3,2] row_mask:0xf bank_mask:0xf\n\tv_add_f32_dpp %1, %1, %1 quad_perm:[1,0,3,2] row_mask:0xf bank_mask:0xf\n\t"
        "v_add_f32_dpp %2, %2, %2 quad_perm:[1,0,3,2] row_mask:0xf bank_mask:0xf\n\tv_add_f32_dpp %3, %3, %3 quad_perm:[1,0,3,2] row_mask:0xf bank_mask:0xf\n\t"
        "v_add_f32_dpp %0, %0, %0 quad_perm:[2,3,0,1] row_mask:0xf bank_mask:0xf\n\tv_add_f32_dpp %1, %1, %1 quad_perm:[2,3,0,1] row_mask:0xf bank_mask:0xf\n\t"
        "v_add_f32_dpp %2, %2, %2 quad_perm:[2,3,0,1] row_mask:0xf bank_mask:0xf\n\tv_add_f32_dpp %3, %3, %3 quad_perm:[2,3,0,1] row_mask:0xf bank_mask:0xf\n\t"
        "v_add_f32_dpp %0, %0, %0 row_half_mirror row_mask:0xf bank_mask:0xf\n\tv_add_f32_dpp %1, %1, %1 row_half_mirror row_mask:0xf bank_mask:0xf\n\t"
        "v_add_f32_dpp %2, %2, %2 row_half_mirror row_mask:0xf bank_mask:0xf\n\tv_add_f32_dpp %3, %3, %3 row_half_mirror row_mask:0xf bank_mask:0xf\n\t"
        "v_add_f32_dpp %0, %0, %0 row_mirror row_mask:0xf bank_mask:0xf\n\tv_add_f32_dpp %1, %1, %1 row_mirror row_mask:0xf bank_mask:0xf\n\t"
        "v_add_f32_dpp %2, %2, %2 row_mirror row_mask:0xf bank_mask:0xf\n\tv_add_f32_dpp %3, %3, %3 row_mirror row_mask:0xf bank_mask:0xf\n\t"
        "s_nop 1"
        : "+v"(a), "+v"(b), "+v"(c), "+v"(d));
}
__device__ __forceinline__ int scan_row(int dir, int b, int t) {
    if (t < CTX) return RL + b * CTX + (dir ? CTX - 1 - t : t);
    const int tl = t - CTX; return b * SEQ + (dir ? SEQ - 1 - tl : tl);
}
__device__ __forceinline__ void readout_rows(Frame& F, bf16* AB) {
    const int gw = __builtin_amdgcn_readfirstlane(blockIdx.x * NWAVES + F.wave), NH = (F.G * NWAVES) >> 1, half = gw & 1, gh = gw >> 1;
    const float* Y0 = (const float*)(F.ws + WS_YD); const float* Y1 = Y0 + (size_t)RT * 1024;
    const int per = (RT + NH - 1) / NH, r0 = gh * per, r1 = min(RT, r0 + per);
    if (r0 >= r1) return;
    const int n0 = half * 512 + 8 * F.lane;
    float ka[8], rk[8], lw[8], lb[8];
#pragma unroll
    for (int e = 0; e < 8; ++e) { ka[e] = KIN(19)[n0 + e]; rk[e] = KIN(20)[n0 + e]; lw[e] = KIN(21)[n0 + e]; lb[e] = KIN(22)[n0 + e]; }
    __builtin_amdgcn_s_waitcnt(0x0F70);
#define RO_LOAD(B, r_) do { const size_t o = (size_t)(r_) * 1024 + n0; B##y0[0] = *(const f32x4*)(Y0 + o); B##y0[1] = *(const f32x4*)(Y0 + o + 4); B##y1[0] = *(const f32x4*)(Y1 + o); B##y1[1] = *(const f32x4*)(Y1 + o + 4); \
        B##r = *(const v4u*)(FEAT(FE_R) + o); B##k = *(const v4u*)(FEAT(FE_K) + o); B##a0 = *(const v4u*)(FEAT(FE_A0) + o); B##a1 = *(const v4u*)(FEAT(FE_A0 + 2) + o); B##v = *(const v4u*)(FEAT(FE_V) + o);     \
        B##g = *(const v4u*)(AB + (size_t)(r_) * D + 1024 + n0); asm volatile("" ::: "memory"); __builtin_amdgcn_sched_barrier(0); } while (0)
#define RO_ROW(B, r_) do { float y[8];                                                                                                                         \
        _Pragma("unroll") for (int e = 0; e < 4; ++e) { y[e] = B##y0[0][e] + B##y1[0][e]; y[4 + e] = B##y0[1][e] + B##y1[1][e]; }                                   \
        float s = 0.f;                                                                                                                                             \
        _Pragma("unroll") for (int e = 0; e < 8; ++e) s += y[e];                                                                                                    \
        s += __shfl_xor(s, 1); s += __shfl_xor(s, 2); s += __shfl_xor(s, 4); const float mu = s * (1.0f / 64.0f);                                                  \
        float q = 0.f;                                                                                                                                             \
        _Pragma("unroll") for (int e = 0; e < 8; ++e) { const float d = y[e] - mu; q += d * d; }                                                                    \
        q += __shfl_xor(q, 1); q += __shfl_xor(q, 2); q += __shfl_xor(q, 4); const float rstd = 1.0f / sqrtf(q * (1.0f / 64.0f) + 64e-5f);                          \
        float rr[8], kx[8], a0[8], a1[8], vv[8], gg[8];                                                                                                            \
        unpack8(B##r, rr); unpack8(B##k, kx); unpack8(B##a0, a0); unpack8(B##a1, a1); unpack8(B##v, vv); unpack8(B##g, gg);                                           \
        float bs = 0.f;                                                                          \
        _Pragma("unroll") for (int e = 0; e < 8; ++e) bs += rr[e] * kx[e] * (2.0f + (a0[e] + a1[e] - 2.0f) * ka[e]) * rk[e];                                         \
        bs += __shfl_xor(bs, 1); bs += __shfl_xor(bs, 2); bs += __shfl_xor(bs, 4);                                                                                 \
        float ob[8];                                                                                                                                               \
        _Pragma("unroll") for (int e = 0; e < 8; ++e) ob[e] = ((y[e] - mu) * rstd * lw[e] + lb[e] + bs * vv[e]) * gg[e];                                             \
        RO_STORE(r_); asm volatile("" ::: "memory"); __builtin_amdgcn_sched_barrier(0); } while (0)
#ifdef WO0_F8
#define RO_STORE(r_) do { v2u w_; w_.x = pk4_fp8(SC_A8 * ob[0], SC_A8 * ob[1], SC_A8 * ob[2], SC_A8 * ob[3]); w_.y = pk4_fp8(SC_A8 * ob[4], SC_A8 * ob[5], SC_A8 * ob[6], SC_A8 * ob[7]); *(v2u*)((unsigned char*)AB + (size_t)(r_) * (2 * D) + 1024 + n0) = w_; } while (0)
#else
#define RO_STORE(r_) do { *(v4u*)(AB + (size_t)(r_) * D + 1024 + n0) = pack8(ob); } while (0)
#endif
    f32x4 Ay0[2], Ay1[2], By0[2], By1[2]; v4u Ar, Ak, Aa0, Aa1, Av, Ag, Br, Bk, Ba0, Ba1, Bv, Bg;
    RO_LOAD(A, r0);
    __builtin_amdgcn_s_waitcnt(0x0F70);
#pragma unroll 1
    for (int r = r0; r < r1; r += 2) {
        __builtin_amdgcn_s_waitcnt(0x0F71);
        if (r + 1 < r1) RO_LOAD(B, r + 1);
        RO_ROW(A, r);
        if (r + 1 < r1) { __builtin_amdgcn_s_waitcnt(0x0F71); if (r + 2 < r1) RO_LOAD(A, r + 2); RO_ROW(B, r + 1); }
    }
#undef RO_LOAD
#undef RO_ROW
#undef RO_STORE
}
__device__ __forceinline__ void zero_ab_right(Frame& F, bf16* AB) {
    const size_t gt = (size_t)blockIdx.x * 512 + F.tid, NGT = (size_t)F.G * 512;
    for (size_t i = gt; i < (size_t)RT * 128; i += NGT) { const size_t r = i >> 7, c = (i & 127) * 8; *(v4u*)(AB + r * D + 1024 + c) = (v4u){0u, 0u, 0u, 0u}; }
}

namespace sc2 {
constexpr int C = 16, SLOT = 12544, NSLOT = 8, HS_OFF = SLOT * NSLOT, HS_SZ = 4096, CV_OFF = HS_OFF + 4 * HS_SZ;
constexpr int O_KKT = 0, O_RT = 2048, O_VT = 4096, O_KGT = 6144, O_BGT = 8192, O_Z1 = 10240, O_Z2 = 10752, O_TM = 11264, O_NBR = 11776, O_GC = 12288;
constexpr int H_BT = 0, H_KDT = 2048;
static_assert(CV_OFF + 4 * 8192 <= MISC_OFF && 6 * 2048 <= SLOT, "scan LDS map");
__device__ __forceinline__ f32x4 mfma16(s16x4 a, s16x4 b, f32x4 c) { return __builtin_amdgcn_mfma_f32_16x16x16bf16_1k(a, b, c, 0, 0, 0); }
__device__ __forceinline__ f32x4 mfma32(bf16x8 a, bf16x8 b, f32x4 c) { return __builtin_amdgcn_mfma_f32_16x16x32_bf16(a, b, c, 0, 0, 0); }
__device__ __forceinline__ s16x4 pack4(f32x4 x) { v2u w; w.x = pk2(x[0], x[1]); w.y = pk2(x[2], x[3]); return __builtin_bit_cast(s16x4, w); }
__device__ __forceinline__ f32x4 unpack4(v2u w) { return (f32x4){bflo(w.x), bfhi(w.x), bflo(w.y), bfhi(w.y)}; }
template <int OFF> __device__ __forceinline__ v2u trr(int a) { v2u r; asm volatile("ds_read_b64_tr_b16 %0, %1 offset:%2" : "=&v"(r) : "v"(a), "i"(OFF) : "memory"); return r; }
template <int OFF> __device__ __forceinline__ v2u rd64(int a) { v2u r; asm volatile("ds_read_b64 %0, %1 offset:%2" : "=&v"(r) : "v"(a), "i"(OFF) : "memory"); return r; }
#define TIE4(a, b, c, d) asm volatile("s_waitcnt lgkmcnt(0)" : "+v"(a), "+v"(b), "+v"(c), "+v"(d) :: "memory")
#define TIE1(a) asm volatile("s_waitcnt lgkmcnt(0)" : "+v"(a) :: "memory")
__device__ __forceinline__ bf16x8 cat2(v2u a, v2u b) { const v4u q = {a.x, a.y, b.x, b.y}; return __builtin_bit_cast(bf16x8, q); }
__device__ __forceinline__ s16x4 as4(v2u a) { return __builtin_bit_cast(s16x4, a); }
__device__ __forceinline__ int sw16(int r) { return (((r >> 2) ^ (r >> 3)) & 1) << 4; }

__device__ __forceinline__ void h_load(v4u (&ld)[12], const bf16* const (&arr)[6], int dir, int b, int h, int t0, int lane) {
#pragma unroll
    for (int m = 0; m < 2; ++m) { const int pi = lane + 64 * m, t = pi >> 3, c8 = pi & 7; const size_t ro = (size_t)scan_row(dir, b, t0 + t) * 1024 + h * 64 + c8 * 8;
#pragma unroll
        for (int a = 0; a < 6; ++a) ld[a * 2 + m] = *(const v4u*)(arr[a] + ro); }
}
__device__ __forceinline__ void helper_chunk(v4u (&ld)[12], LAS unsigned char* slot, LAS unsigned char* hs, int lane, float kac) {
    const int l15 = lane & 15, g = lane >> 4, q = (lane >> 2) & 3, p = lane & 3;
    const int sb = (int)(uintptr_t)slot, hb = (int)(uintptr_t)hs;
    { LAS unsigned char* wp = slot + (lane >> 3) * 128 + (((lane & 7) * 16) ^ (((lane >> 4) & 1) * 64));
#pragma unroll
      for (int a = 0; a < 6; ++a) { *(LAS v4u*)(wp + a * 2048) = ld[2 * a]; *(LAS v4u*)(wp + a * 2048 + 1024) = ld[2 * a + 1]; } }
    LDS_WAIT(); asm volatile("" ::: "memory");
    const int rb = sb + q * 128 + ((g * 32 + p * 8) ^ ((q >> 1) * 64));
    v2u re[4], rk[4], ra[4], rkk[4], rr[4], rv[4];
    re[0] = trr<0>(rb); re[1] = trr<512>(rb); re[2] = trr<1024>(rb); re[3] = trr<1536>(rb);
    rkk[0] = trr<2048>(rb); rkk[1] = trr<2048 + 512>(rb); rkk[2] = trr<2048 + 1024>(rb); rkk[3] = trr<2048 + 1536>(rb);
    ra[0] = trr<4096>(rb); ra[1] = trr<4096 + 512>(rb); ra[2] = trr<4096 + 1024>(rb); ra[3] = trr<4096 + 1536>(rb);
    rk[0] = trr<6144>(rb); rk[1] = trr<6144 + 512>(rb); rk[2] = trr<6144 + 1024>(rb); rk[3] = trr<6144 + 1536>(rb);
    rr[0] = trr<8192>(rb); rr[1] = trr<8192 + 512>(rb); rr[2] = trr<8192 + 1024>(rb); rr[3] = trr<8192 + 1536>(rb);
    rv[0] = trr<10240>(rb); rv[1] = trr<10240 + 512>(rb); rv[2] = trr<10240 + 1024>(rb); rv[3] = trr<10240 + 1536>(rb);
    TIE4(re[0], re[1], re[2], re[3]); TIE4(rkk[0], rkk[1], rkk[2], rkk[3]); TIE4(ra[0], ra[1], ra[2], ra[3]); TIE4(rk[0], rk[1], rk[2], rk[3]); TIE4(rr[0], rr[1], rr[2], rr[3]); TIE4(rv[0], rv[1], rv[2], rv[3]);
    const int wo0 = lane * 32 + sw16(lane), wo1 = lane * 32 + (16 ^ sw16(lane));
    float lgs[16];
    { float l = 0.f;
#pragma unroll
      for (int i = 0; i < 4; ++i) { const f32x4 e4 = unpack4(re[i]);
#pragma unroll
          for (int j = 0; j < 4; ++j) { l -= e4[j]; lgs[4 * i + j] = l; } } }
    { const float gC = fast_exp(lgs[15]); float gprev = 1.0f;
      unsigned okk[8], orr[8], ob[8], okd[8], oyb[8], oyk[8];
#pragma unroll
      for (int i = 0; i < 4; ++i) { const f32x4 kk4 = unpack4(rkk[i]), a4 = unpack4(ra[i]), k4 = unpack4(rk[i]), r4 = unpack4(rr[i]);
          float vkk[4], vr[4], vb[4], vkd[4], vyb[4], vyk[4];
#pragma unroll
          for (int j = 0; j < 4; ++j) { const int t = 4 * i + j; const float gt = fast_exp(lgs[t]), ig = __builtin_amdgcn_rcpf(gt), rC = gC * ig, gm = gprev; gprev = gt;
              const float kka = kk4[j] * a4[j], kd = k4[j] * (1.0f + (a4[j] - 1.0f) * kac);
              vkk[j] = kk4[j] * gm; vr[j] = r4[j] * gt; vb[j] = kka * ig; vkd[j] = kd * ig; vyb[j] = -kka * rC; vyk[j] = kd * rC; }
          okk[2 * i] = pk2(vkk[0], vkk[1]); okk[2 * i + 1] = pk2(vkk[2], vkk[3]); orr[2 * i] = pk2(vr[0], vr[1]); orr[2 * i + 1] = pk2(vr[2], vr[3]);
          ob[2 * i] = pk2(vb[0], vb[1]); ob[2 * i + 1] = pk2(vb[2], vb[3]); okd[2 * i] = pk2(vkd[0], vkd[1]); okd[2 * i + 1] = pk2(vkd[2], vkd[3]);
          oyb[2 * i] = pk2(vyb[0], vyb[1]); oyb[2 * i + 1] = pk2(vyb[2], vyb[3]); oyk[2 * i] = pk2(vyk[0], vyk[1]); oyk[2 * i + 1] = pk2(vyk[2], vyk[3]); }
#define ST16S(base, o) do { *(LAS v4u*)((base) + wo0) = (v4u){o[0], o[1], o[2], o[3]}; *(LAS v4u*)((base) + wo1) = (v4u){o[4], o[5], o[6], o[7]}; } while (0)
      ST16S(slot + O_KKT, okk); ST16S(slot + O_RT, orr); ST16S(hs + H_BT, ob); ST16S(hs + H_KDT, okd); ST16S(slot + O_BGT, oyb); ST16S(slot + O_KGT, oyk);
#undef ST16S
      *(LAS v4u*)(slot + O_VT + wo0) = (v4u){rv[0].x, rv[0].y, rv[1].x, rv[1].y}; *(LAS v4u*)(slot + O_VT + wo1) = (v4u){rv[2].x, rv[2].y, rv[3].x, rv[3].y};
      *(LAS float*)(slot + O_GC + lane * 4) = gC; }
    LDS_WAIT(); asm volatile("" ::: "memory");
    f32x4 g1 = {0.f, 0.f, 0.f, 0.f}, g2 = g1, g3 = g1, g4 = g1, g1b = g1;
    { const int a0 = (8 * g + q) * 32 + ((p * 8) ^ ((g & 1) * 16)), a1 = (8 * g + 4 + q) * 32 + ((p * 8) ^ (((g & 1) ^ 1) * 16));
      v2u b00 = trr<H_BT>(hb + a0), b01 = trr<H_BT>(hb + a1), b10 = trr<H_BT + 1024>(hb + a0), b11 = trr<H_BT + 1024>(hb + a1);
      v2u d00 = trr<H_KDT>(hb + a0), d01 = trr<H_KDT>(hb + a1), d10 = trr<H_KDT + 1024>(hb + a0), d11 = trr<H_KDT + 1024>(hb + a1);
      v2u k00 = trr<O_KKT>(sb + a0), k01 = trr<O_KKT>(sb + a1), k10 = trr<O_KKT + 1024>(sb + a0), k11 = trr<O_KKT + 1024>(sb + a1);
      v2u r00 = trr<O_RT>(sb + a0), r01 = trr<O_RT>(sb + a1), r10 = trr<O_RT + 1024>(sb + a0), r11 = trr<O_RT + 1024>(sb + a1);
      TIE4(b00, b01, b10, b11); TIE4(d00, d01, d10, d11); TIE4(k00, k01, k10, k11); TIE4(r00, r01, r10, r11);
      { const bf16x8 aB = cat2(b00, b01), aD = cat2(d00, d01), bK = cat2(k00, k01), bR = cat2(r00, r01);
        g1 = mfma32(aB, bK, g1); g2 = mfma32(aD, bK, g2); g3 = mfma32(aB, bR, g3); g4 = mfma32(aD, bR, g4); g1b = mfma32(bK, aB, g1b); }
      { const bf16x8 aB = cat2(b10, b11), aD = cat2(d10, d11), bK = cat2(k10, k11), bR = cat2(r10, r11);
        g1 = mfma32(aB, bK, g1); g2 = mfma32(aD, bK, g2); g3 = mfma32(aB, bR, g3); g4 = mfma32(aD, bR, g4); g1b = mfma32(bK, aB, g1b); } }
#pragma unroll
    for (int r = 0; r < 4; ++r) { const int j = 4 * g + r; if (!(j < l15)) { g1[r] = 0.f; g2[r] = 0.f; } if (!(j <= l15)) { g3[r] = 0.f; g4[r] = 0.f; } if (!(l15 < j)) g1b[r] = 0.f; }
    const int po = l15 * 32 + ((g * 8) ^ sw16(l15));
    { v2u w; w.x = pk2(-g3[0], -g3[1]); w.y = pk2(-g3[2], -g3[3]); *(LAS v2u*)(slot + O_NBR + po) = w; }
    { const f32x4 z4 = {0.f, 0.f, 0.f, 0.f};
      f32x4 t1a, t1b;
#pragma unroll
      for (int r = 0; r < 4; ++r) { const float dg = (4 * g + r == l15) ? 1.f : 0.f; t1a[r] = dg - g1[r]; t1b[r] = dg - g1b[r]; }
      const s16x4 mA = pack4(g1), mB = pack4(g1b);
      const f32x4 s2b = mfma16(mA, mB, z4), s2a = mfma16(mB, mA, z4);
      const s16x4 s2A = pack4(s2a), s2B = pack4(s2b);
      const f32x4 s4b = mfma16(s2A, s2B, z4), s4a = mfma16(s2B, s2A, z4);
      const s16x4 s4A = pack4(s4a), s4B = pack4(s4b);
      const f32x4 s8b = mfma16(s4A, s4B, z4);
      const s16x4 t1A = pack4(t1a);
      const f32x4 t2b = mfma16(t1A, s2B, t1b), t2a = mfma16(s2B, t1A, t1a);
      const s16x4 t2A = pack4(t2a);
      const f32x4 t3b = mfma16(t2A, s4B, t2b), t3a = mfma16(s4B, t2A, t2a);
      (void)t3b;
      const f32x4 ta = mfma16(pack4(s8b), pack4(t3a), t3a);
      *(LAS s16x4*)(slot + O_TM + po) = pack4(ta); }
    *(LAS s16x4*)(slot + O_Z1 + po) = pack4(g2); *(LAS s16x4*)(slot + O_Z2 + po) = pack4(g4);
    LDS_WAIT(); asm volatile("" ::: "memory");
}
template <bool STORE = true>
__device__ __forceinline__ void main_chunk(f32x4 (&acc)[4], const LAS unsigned char* slot, int w, int lane, float* YD, int dir, int b, int h, int t0) {
    const int l15 = lane & 15, g = lane >> 4, q = (lane >> 2) & 3, p = lane & 3;
    const int sb = (int)(uintptr_t)slot;
    const int po = sb + l15 * 32 + ((g * 8) ^ sw16(l15));
    const int mb = sb + (4 * g + q) * 32 + ((p * 8) ^ sw16(4 * g + q));
    v2u k00 = trr<O_KKT>(mb), k01 = trr<O_KKT + 512>(mb), k10 = trr<O_KKT + 1024>(mb), k11 = trr<O_KKT + 1536>(mb);
    v2u r00 = trr<O_RT>(mb), r01 = trr<O_RT + 512>(mb), r10 = trr<O_RT + 1024>(mb), r11 = trr<O_RT + 1536>(mb);
    v2u vbr = rd64<0>(po + O_VT + 512 * w), z1 = rd64<O_Z1>(po), z2 = rd64<O_Z2>(po), tm = rd64<O_TM>(po), nbr = rd64<O_NBR>(po);
    v2u kg0 = rd64<O_KGT>(po), kg1 = rd64<O_KGT + 512>(po), kg2 = rd64<O_KGT + 1024>(po), kg3 = rd64<O_KGT + 1536>(po);
    v2u bg0 = rd64<O_BGT>(po), bg1 = rd64<O_BGT + 512>(po), bg2 = rd64<O_BGT + 1024>(po), bg3 = rd64<O_BGT + 1536>(po);
    bf16x8 sbk[2];
#pragma unroll
    for (int ks = 0; ks < 2; ++ks) { v4u c; c.x = pk2(acc[2 * ks][0], acc[2 * ks][1]); c.y = pk2(acc[2 * ks][2], acc[2 * ks][3]); c.z = pk2(acc[2 * ks + 1][0], acc[2 * ks + 1][1]); c.w = pk2(acc[2 * ks + 1][2], acc[2 * ks + 1][3]); sbk[ks] = __builtin_bit_cast(bf16x8, c); }
    f32x4 gc[4];
#pragma unroll
    for (int kt = 0; kt < 4; ++kt) gc[kt] = *(const LAS f32x4*)(slot + O_GC + (16 * kt + 4 * g) * 4);
    TIE4(k00, k01, k10, k11); TIE4(r00, r01, r10, r11); TIE4(vbr, z1, z2, tm); TIE4(nbr, kg0, kg1, kg2); TIE4(kg3, bg0, bg1, bg2); TIE1(bg3);
    const s16x4 vb = as4(vbr);
    f32x4 x1 = mfma16(as4(z1), vb, (f32x4){0.f, 0.f, 0.f, 0.f}), x2 = mfma16(as4(z2), vb, (f32x4){0.f, 0.f, 0.f, 0.f});
    x1 = mfma32(cat2(k00, k01), sbk[0], x1); x2 = mfma32(cat2(r00, r01), sbk[0], x2);
    x1 = mfma32(cat2(k10, k11), sbk[1], x1); x2 = mfma32(cat2(r10, r11), sbk[1], x2);
    const f32x4 u = mfma16(as4(tm), pack4(x1), (f32x4){0.f, 0.f, 0.f, 0.f});
    const s16x4 ub = pack4(u);
    const f32x4 y = mfma16(as4(nbr), ub, x2);
    if (STORE) {
#pragma unroll
    for (int r = 0; r < 4; ++r) YD[(size_t)scan_row(dir, b, t0 + 4 * g + r) * 1024 + h * 64 + 16 * w + l15] = y[r]; }
    else { asm volatile("" :: "v"(y)); }
    acc[0] = mfma16(as4(bg0), ub, mfma16(as4(kg0), vb, acc[0] * gc[0])); acc[1] = mfma16(as4(bg1), ub, mfma16(as4(kg1), vb, acc[1] * gc[1]));
    acc[2] = mfma16(as4(bg2), ub, mfma16(as4(kg2), vb, acc[2] * gc[2])); acc[3] = mfma16(as4(bg3), ub, mfma16(as4(kg3), vb, acc[3] * gc[3]));
}
__device__ __forceinline__ void scan_unit2(Frame& F, int u) {
    constexpr int T = CTX + SEQ, NG = T / (4 * C);
    const int dir = u & 1, b = u >> 5, h = (u >> 1) & 15;
    const bf16* const arr[6] = {FEAT(FE_E0 + 2 * dir), FEAT(FE_KK), FEAT(FE_A0 + 2 * dir), FEAT(FE_K), FEAT(FE_R), FEAT(FE_V)};
    const float kac = KIN(19)[h * 64 + F.lane];
    float* YD = (float*)(F.ws + WS_YD) + (size_t)dir * RT * 1024;
    const bool helper = F.wave >= 4; int hw = F.wave & 3; int lane = F.lane;
    __builtin_amdgcn_s_waitcnt(0x0F70);
    asm volatile("" : "+s"(hw), "+v"(lane));
    LAS unsigned char* hs = F.lds + HS_OFF + hw * HS_SZ;
    if (helper) {
#ifdef SCAN_HPRIO
        __builtin_amdgcn_s_setprio(2);
#endif
        v4u ld[12], ln[12];
        h_load(ld, arr, dir, b, h, hw * C, lane);
        helper_chunk(ld, F.lds + hw * SLOT, hs, lane, kac);
        if (NG > 1) h_load(ln, arr, dir, b, h, (4 + hw) * C, lane);
        __syncthreads();
#pragma unroll 1
        for (int G = 0; G < NG; ++G) {
            if (G + 1 < NG) {
#pragma unroll
                for (int i = 0; i < 12; ++i) ld[i] = ln[i];
                if (G + 2 < NG) h_load(ln, arr, dir, b, h, (4 * (G + 2) + hw) * C, lane);
#ifdef SCANP_H
#pragma unroll 1
                for (int rep = 0; rep < SCANP_H; ++rep)
#endif
                helper_chunk(ld, F.lds + (((G + 1) & 1) * 4 + hw) * SLOT, hs, lane, kac); }
            __syncthreads();
        }
#ifdef SCAN_HPRIO
        __builtin_amdgcn_s_setprio(0);
#endif
    } else {
        f32x4 acc[4];
#pragma unroll
        for (int kt = 0; kt < 4; ++kt) acc[kt] = (f32x4){0.f, 0.f, 0.f, 0.f};
#ifdef SCAN_CVPIPE
        constexpr int SH = TI_NQ / 8; const int shard = blockIdx.x & 7;
        LAS float* scr = (LAS float*)(F.lds + CV_OFF + hw * 8192);
        int cq = -1; f32x4 c0[8], c1[8];
#define CV_GRAB() do { unsigned q_ = 0; if (lane == 0) q_ = __hip_atomic_fetch_add(F.ctl + CW_CQ + 64 * shard, 2u, __ATOMIC_RELAXED, __HIP_MEMORY_SCOPE_AGENT); q_ = (unsigned)__builtin_amdgcn_readfirstlane((int)q_); \
            cq = -1; if (q_ < (unsigned)SH) { cq = shard * SH + (int)q_; const TrItem t0 = tr_decode(F, cq), t1 = tr_decode(F, cq + 1); tr_load(t0, c0, lane); tr_load(t1, c1, lane); } } while (0)
        CV_GRAB();
        __syncthreads();
#pragma unroll 1
        for (int G = 0; G < NG; ++G) {
#pragma unroll
            for (int c = 0; c < 4; ++c) main_chunk(acc, F.lds + ((G & 1) * 4 + c) * SLOT, hw, lane, YD, dir, b, h, (4 * G + c) * C);
            if (cq >= 0) { __builtin_amdgcn_s_waitcnt(0x4F70);
                const TrItem t0 = tr_decode(F, cq); tr_store(t0, c0, scr, lane); const TrItem t1 = tr_decode(F, cq + 1); tr_store(t1, c1, scr, lane); cq = -1; }
            if (G + 1 < NG) CV_GRAB();
            __syncthreads();
        }
#undef CV_GRAB
#else
        __syncthreads();
#pragma unroll 1
        for (int G = 0; G < NG; ++G) {
#pragma unroll 1
            for (int c = 0; c < 4; ++c) main_chunk(acc, F.lds + ((G & 1) * 4 + c) * SLOT, hw, lane, YD, dir, b, h, (4 * G + c) * C);
#ifdef SCANP_M
            { f32x4 acd[4];
#pragma unroll
              for (int kt = 0; kt < 4; ++kt) acd[kt] = acc[kt];
#pragma unroll 1
              for (int c = 0; c < 4; ++c) main_chunk<(SCANP_M > 1)>(acd, F.lds + ((G & 1) * 4 + c) * SLOT, hw, lane, (float*)(F.ws + WS_ACTB), dir, b, h, (4 * G + c) * C); }
#endif
#ifndef SCANP_NOCV
            if (G + 1 < NG) convert_grab(F, (LAS float*)(F.lds + CV_OFF + hw * 8192));
#endif
            __syncthreads();
        }
#endif
    }
}
}

constexpr size_t WS_ROPE = WS_CTL + 512 * 1024;
constexpr int LDQKV = 3 * D;
constexpr float QSCALE = 0.125f * 1.4426950408889634f;
__device__ __forceinline__ void p0_rope_table(Frame& F) {
    float* RT_ = WSP(float, WS_ROPE);
    const int gt = blockIdx.x * 512 + F.tid, NGT = F.G * 512;
    for (int i = gt; i < SEQ * 32; i += NGT) { const int t = i >> 5, j2 = i & 31, ax = j2 >> 4, j = j2 & 15;
        const float inv = powf(10000.0f, -(float)j / 16.0f), th = (float)(ax ? (t & 63) : (t >> 6)) * inv; RT_[2 * i] = cosf(th); RT_[2 * i + 1] = sinf(th); }
}
__device__ __forceinline__ float dpp_x1(float v) { return __builtin_bit_cast(float, __builtin_amdgcn_update_dpp(0, __builtin_bit_cast(int, v), 0xB1, 0xF, 0xF, true)); }
__device__ __forceinline__ float dpp_x2(float v) { return __builtin_bit_cast(float, __builtin_amdgcn_update_dpp(0, __builtin_bit_cast(int, v), 0x4E, 0xF, 0xF, true)); }
__device__ __forceinline__ float dpp_hm(float v) { return __builtin_bit_cast(float, __builtin_amdgcn_update_dpp(0, __builtin_bit_cast(int, v), 0x141, 0xF, 0xF, true)); }
template <bool LAT>
__device__ __forceinline__ void qknorm_rope_seg(Frame& F, bf16* QKV, int s0, int send, const float (&gq)[8], const float (&gk)[8]) {
    constexpr int J0 = LAT ? 0 : 4;
    const float* RT_ = WSP(float, WS_ROPE);
    const int t = F.lane & 7, co = 2 * ((t >> 2) * 16 + 8 * (t & 1));
    const float sgn = (t & 2) ? 1.0f : -1.0f;
#define QK_LOAD(B, C, r_) do { const v4u* p_ = (const v4u*)(QKV + (size_t)(r_) * LDQKV); _Pragma("unroll") for (int j = J0; j < 8; ++j) B[j] = p_[F.lane + 64 * j];                     \
        if (LAT) { const f32x4* c_ = (const f32x4*)(RT_ + (size_t)((r_) & (SEQ - 1)) * 64 + co); _Pragma("unroll") for (int q = 0; q < 4; ++q) C[q] = c_[q]; }                              \
        asm volatile("" ::: "memory"); __builtin_amdgcn_sched_barrier(0); } while (0)
#define QK_ROW(B, C, r_) do { v4u* p_ = (v4u*)(QKV + (size_t)(r_) * LDQKV);                                                                                                          \
        _Pragma("unroll") for (int j = J0; j < 8; ++j) { float x[8]; unpack8(B[j], x); float ss = 0.f;                                                                                   \
            _Pragma("unroll") for (int e = 0; e < 8; ++e) ss += x[e] * x[e];                                                                                                            \
            ss += dpp_x1(ss); ss += dpp_x2(ss); ss += dpp_hm(ss);                                                                                                                      \
            const float rstd = 1.0f / sqrtf(ss * (1.0f / 64.0f) + 1e-6f);                                                                                                               \
            _Pragma("unroll") for (int e = 0; e < 8; ++e) x[e] = x[e] * rstd * (j < 4 ? gq[e] : gk[e]);                                                                                  \
            if (LAT) { _Pragma("unroll") for (int e = 0; e < 8; ++e) { const float c = C[e >> 1][(e & 1) * 2], s = C[e >> 1][(e & 1) * 2 + 1]; const float o_ = dpp_x2(x[e]); x[e] = x[e] * c + o_ * (sgn * s); } } \
            p_[F.lane + 64 * j] = pack8(x); }                                                                                                                                          \
        asm volatile("" ::: "memory"); __builtin_amdgcn_sched_barrier(0); } while (0)
    v4u A[8], B[8]; f32x4 CA[4], CB[4];
    QK_LOAD(A, CA, s0);
    __builtin_amdgcn_s_waitcnt(0x0F70);
#pragma unroll 1
    for (int r = s0; r < send; r += 2) {
        __builtin_amdgcn_s_waitcnt(LAT ? 0x0F78 : 0x0F74);
        if (r + 1 < send) QK_LOAD(B, CB, r + 1);
        QK_ROW(A, CA, r);
        if (r + 1 < send) { __builtin_amdgcn_s_waitcnt(LAT ? 0x0F78 : 0x0F74); if (r + 2 < send) QK_LOAD(A, CA, r + 2); QK_ROW(B, CB, r + 1); }
    }
    __builtin_amdgcn_s_waitcnt(0x0F70);
#undef QK_LOAD
#undef QK_ROW
}
__device__ __forceinline__ void qknorm_rope_rows(Frame& F, bf16* QKV) {
    const int gw = __builtin_amdgcn_readfirstlane(blockIdx.x * NWAVES + F.wave), NGW = F.G * NWAVES;
    const int per = (RT + NGW - 1) / NGW, r0 = gw * per, r1 = min(RT, r0 + per);
    if (r0 >= r1) return;
    const int t = F.lane & 7; float gq[8], gk[8];
#pragma unroll
    for (int e = 0; e < 8; ++e) { gq[e] = KIN(32)[8 * t + e] * QSCALE; gk[e] = KIN(33)[8 * t + e]; }
    __builtin_amdgcn_s_waitcnt(0x0F70);
    if (r0 < RL) qknorm_rope_seg<true>(F, QKV, r0, min(r1, RL), gq, gk);
    if (r1 > RL) qknorm_rope_seg<false>(F, QKV, max(r0, RL), r1, gq, gk);
}

namespace att {
constexpr int KVBLK = 64, NT = (CTX + SEQ) / KVBLK;
constexpr int SHM_V = KVBLK * 128 * 2, SHM_K = KVBLK * 64 * 2;
#define KSWZ64(row, colB) ((row) * 128 + ((colB) ^ ((((row) >> 1) & 7) << 4)))
#define SBAR() __builtin_amdgcn_sched_barrier(0)
__device__ __forceinline__ int crow(int r, int hi) { return (r & 3) + 8 * (r >> 2) + 4 * hi; }
__device__ __forceinline__ unsigned cvtpk(float lo, float hi) { unsigned r; asm volatile("v_cvt_pk_bf16_f32 %0, %1, %2" : "=v"(r) : "v"(lo), "v"(hi)); return r; }
__device__ __forceinline__ int v_st(int k, int c) { const int kk = (k & ~0xC) | ((k & 4) << 1) | ((k & 8) >> 1); return ((kk >> 3) * 4 + (c >> 5)) * 512 + ((kk & 7) * 32 + (c & 31)) * 2; }
__device__ __forceinline__ int v_rd_base(int lane) { return ((lane & 3) << 3) | (((lane >> 2) & 3) << 6) | (((lane >> 4) & 1) << 5) | (((lane >> 5) & 1) << 8); }
constexpr int v_rd_off(int d0, int ks, int half) { return d0 * 512 + ks * 4096 + half * 2048; }
template <int OFF> __device__ __forceinline__ s16x4 tr_read(int vb) { s16x4 r; asm volatile("ds_read_b64_tr_b16 %0, %1 offset:%2" : "=&v"(r) : "v"(vb), "i"(OFF) : "memory"); return r; }
template <int D0, bool PRIO = false> __device__ __forceinline__ void pv_one(f32x16& od, int vb, bf16x8 pa0, bf16x8 pa1, bf16x8 pa2, bf16x8 pa3) {
    const s16x4 l0 = tr_read<v_rd_off(D0, 0, 0)>(vb), h0 = tr_read<v_rd_off(D0, 0, 1)>(vb), l1 = tr_read<v_rd_off(D0, 1, 0)>(vb), h1 = tr_read<v_rd_off(D0, 1, 1)>(vb);
    const s16x4 l2 = tr_read<v_rd_off(D0, 2, 0)>(vb), h2 = tr_read<v_rd_off(D0, 2, 1)>(vb), l3 = tr_read<v_rd_off(D0, 3, 0)>(vb), h3 = tr_read<v_rd_off(D0, 3, 1)>(vb);
    asm volatile("s_waitcnt lgkmcnt(0)" ::: "memory"); SBAR();
#define PK(L, H) (bf16x8){L[0], L[1], L[2], L[3], H[0], H[1], H[2], H[3]}
#ifdef ATT_SETPRIO
    if (PRIO) __builtin_amdgcn_s_setprio(1);
#endif
    od = __builtin_amdgcn_mfma_f32_32x32x16_bf16(pa0, PK(l0, h0), od, 0, 0, 0);
    od = __builtin_amdgcn_mfma_f32_32x32x16_bf16(pa1, PK(l1, h1), od, 0, 0, 0);
    od = __builtin_amdgcn_mfma_f32_32x32x16_bf16(pa2, PK(l2, h2), od, 0, 0, 0);
    od = __builtin_amdgcn_mfma_f32_32x32x16_bf16(pa3, PK(l3, h3), od, 0, 0, 0);
#ifdef ATT_SETPRIO
    if (PRIO) __builtin_amdgcn_s_setprio(0);
#endif
#undef PK
}
__device__ __forceinline__ size_t key_row(int b, int j) { return j < CTX ? (size_t)(RL + b * CTX + j) : (size_t)(b * SEQ + j - CTX); }

template <bool ZI>
__device__ __forceinline__ void qkt64(f32x16& p0, f32x16& p1, const LAS char* Ks, const bf16x8* qr, int r32, int hi, float negM) {
    float ini = 0.f;
    if (!ZI) { ini = negM; asm volatile("" : "+v"(ini)); }
#pragma unroll
    for (int r = 0; r < 16; ++r) { p0[r] = ini; p1[r] = ini; }
#pragma unroll
    for (int d0 = 0; d0 < 4; ++d0) { const int cb = (d0 * 16 + hi * 8) * 2;
        const bf16x8 b0 = *(const LAS bf16x8*)(Ks + KSWZ64(r32, cb)), b1 = *(const LAS bf16x8*)(Ks + KSWZ64(32 + r32, cb));
        p0 = __builtin_amdgcn_mfma_f32_32x32x16_bf16(b0, qr[d0], p0, 0, 0, 0);
        p1 = __builtin_amdgcn_mfma_f32_32x32x16_bf16(b1, qr[d0], p1, 0, 0, 0); }
}
__device__ __forceinline__ void partialSM(f32x16& p0) {
#pragma unroll
    for (int r = 0; r < 16; ++r) p0[r] = __builtin_amdgcn_exp2f(p0[r]);
}
__device__ __forceinline__ void finishSM(f32x16& p0, f32x16& p1, float& l_reg, bf16x8& pa0, bf16x8& pa1, bf16x8& pa2, bf16x8& pa3) {
#pragma unroll
    for (int r = 0; r < 16; ++r) p1[r] = __builtin_amdgcn_exp2f(p1[r]);
    float ps = 0.f;
#pragma unroll
    for (int r = 0; r < 16; ++r) ps += p0[r];
#pragma unroll
    for (int r = 0; r < 16; ++r) ps += p1[r];
    { auto rr = __builtin_amdgcn_permlane32_swap(__float_as_uint(ps), __float_as_uint(ps), false, false); ps = __uint_as_float(rr[0]) + __uint_as_float(rr[1]); }
    l_reg += ps;
#define PK4(P, BASE, OUT) do { unsigned a0 = cvtpk(P[BASE + 0], P[BASE + 1]), a1 = cvtpk(P[BASE + 2], P[BASE + 3]);   \
    unsigned b0_ = cvtpk(P[BASE + 4], P[BASE + 5]), b1_ = cvtpk(P[BASE + 6], P[BASE + 7]);                              \
    auto r0 = __builtin_amdgcn_permlane32_swap(a0, b0_, false, false); auto r1 = __builtin_amdgcn_permlane32_swap(a1, b1_, false, false); \
    v4u w_ = {r0[0], r1[0], r0[1], r1[1]}; OUT = __builtin_bit_cast(bf16x8, w_); } while (0)
    PK4(p0, 0, pa0); PK4(p0, 8, pa1); PK4(p1, 0, pa2); PK4(p1, 8, pa3);
#undef PK4
}
#ifdef ATT_PVPIPE
#define PV_RD(X, D0) do { X##0 = tr_read<v_rd_off(D0, 0, 0)>(vb); X##1 = tr_read<v_rd_off(D0, 0, 1)>(vb); X##2 = tr_read<v_rd_off(D0, 1, 0)>(vb); X##3 = tr_read<v_rd_off(D0, 1, 1)>(vb); \
        X##4 = tr_read<v_rd_off(D0, 2, 0)>(vb); X##5 = tr_read<v_rd_off(D0, 2, 1)>(vb); X##6 = tr_read<v_rd_off(D0, 3, 0)>(vb); X##7 = tr_read<v_rd_off(D0, 3, 1)>(vb); } while (0)
#define PV_WAIT(N, X) asm volatile("s_waitcnt lgkmcnt(" #N ")" : "+v"(X##0), "+v"(X##1), "+v"(X##2), "+v"(X##3), "+v"(X##4), "+v"(X##5), "+v"(X##6), "+v"(X##7) :: "memory")
#define PV_PK(L, H) (bf16x8){L[0], L[1], L[2], L[3], H[0], H[1], H[2], H[3]}
#define PV_MM(od, X) do { od = __builtin_amdgcn_mfma_f32_32x32x16_bf16(pa0, PV_PK(X##0, X##1), od, 0, 0, 0); od = __builtin_amdgcn_mfma_f32_32x32x16_bf16(pa1, PV_PK(X##2, X##3), od, 0, 0, 0); \
        od = __builtin_amdgcn_mfma_f32_32x32x16_bf16(pa2, PV_PK(X##4, X##5), od, 0, 0, 0); od = __builtin_amdgcn_mfma_f32_32x32x16_bf16(pa3, PV_PK(X##6, X##7), od, 0, 0, 0); } while (0)
__device__ __forceinline__ void pv_all(f32x16* o, int vb, bf16x8 pa0, bf16x8 pa1, bf16x8 pa2, bf16x8 pa3) {
    s16x4 A0, A1, A2, A3, A4, A5, A6, A7, B0, B1, B2, B3, B4, B5, B6, B7;
    PV_RD(A, 0); PV_RD(B, 1);
    PV_WAIT(8, A); SBAR(); PV_MM(o[0], A); SBAR();
    PV_RD(A, 2);
    PV_WAIT(8, B); SBAR(); PV_MM(o[1], B); SBAR();
    PV_RD(B, 3);
    PV_WAIT(8, A); SBAR(); PV_MM(o[2], A); SBAR();
    PV_WAIT(0, B); SBAR(); PV_MM(o[3], B);
}
#undef PV_RD
#undef PV_WAIT
#undef PV_PK
#undef PV_MM
#else
template <bool PRIO = false>
__device__ __forceinline__ void pv_all(f32x16* o, int vb, bf16x8 pa0, bf16x8 pa1, bf16x8 pa2, bf16x8 pa3) {
    pv_one<0, PRIO>(o[0], vb, pa0, pa1, pa2, pa3); pv_one<1, PRIO>(o[1], vb, pa0, pa1, pa2, pa3); pv_one<2, PRIO>(o[2], vb, pa0, pa1, pa2, pa3); pv_one<3, PRIO>(o[3], vb, pa0, pa1, pa2, pa3);
}
#endif
template <bool ZI>
__device__ __forceinline__ void attn_unit(Frame& F, int u, const bf16* QKV, bf16* AO, float negM, float lam, float rsc) {
    const int x8 = u & 7, w = u >> 3, qt = w & 7, combo = (w >> 3) * 8 + x8;
    const int h = combo & 15, b = combo >> 4;
    asm volatile("" : "+s"(QKV), "+s"(AO));
    int lane; asm volatile("v_mbcnt_lo_u32_b32 %0, -1, 0\n\tv_mbcnt_hi_u32_b32 %0, -1, %0" : "=v"(lane));
    const int wid = F.wave, tid = wid * 64 + lane, r32 = lane & 31, hi = lane >> 5;
    LAS char* lds = (LAS char*)F.lds;
#ifdef ATT_3BUF
    constexpr int NB = 3;
#else
    constexpr int NB = 2;
#endif
    LAS char* V_lds = lds; LAS char* K_lds = lds + NB * SHM_V; LAS float* li_l = (LAS float*)(lds + NB * SHM_V + NB * SHM_K) + wid * 64;
    LAS char* park = lds + NB * SHM_V + NB * SHM_K + 2048 + wid * 8192;
    const bf16* Vc = QKV + 2 * D + h * 128;
    const int ksr = tid >> 3, ksc = (tid & 7) * 8;
    const int vsr = tid >> 4, vsc = (tid & 15) * 8, vst0 = v_st(vsr, vsc), vst1 = v_st(32 + vsr, vsc);
    const int vb0 = (int)(uintptr_t)V_lds + v_rd_base(lane);
    struct { v4u k, v0, v1; } sr_[1];
#define SLOAD(i, j0) do { sr_[i].k = *(const v4u*)(Kc + key_row(b, (j0) + ksr) * LDQKV + ksc); sr_[i].v0 = *(const v4u*)(Vc + key_row(b, (j0) + vsr) * LDQKV + vsc); sr_[i].v1 = *(const v4u*)(Vc + key_row(b, (j0) + 32 + vsr) * LDQKV + vsc); } while (0)
#define SWRITE(bi, i) do { *(LAS v4u*)(K_lds + (bi) * SHM_K + KSWZ64(ksr, ksc * 2)) = sr_[i].k; *(LAS v4u*)(V_lds + (bi) * SHM_V + vst0) = sr_[i].v0; *(LAS v4u*)(V_lds + (bi) * SHM_V + vst1) = sr_[i].v1; } while (0)
#define SWAIT() asm volatile("s_waitcnt vmcnt(0)" ::: "memory")
#pragma unroll 1
    for (int sub = 0; sub < 2; ++sub) {
    const bf16* Qw = QKV + (size_t)(b * SEQ + qt * 256 + wid * 32 + r32) * LDQKV + h * 128 + sub * 64 + hi * 8;
    bf16x8 qr[4];
#pragma unroll
    for (int d0 = 0; d0 < 4; ++d0) qr[d0] = *(const bf16x8*)(Qw + d0 * 16);
    const bf16* Kc = QKV + D + h * 128 + sub * 64;
    f32x16 o[4] = {}; float l_reg = 0.f;
    f32x16 pA0, pA1, pB0, pB1; bf16x8 pa0, pa1, pa2, pa3;
    SLOAD(0, 0); asm volatile("s_waitcnt vmcnt(0)" ::: "memory"); SWRITE(0, 0); __syncthreads();
    qkt64<ZI>(pA0, pA1, K_lds, qr, r32, hi, negM); partialSM(pA0);
    SLOAD(0, KVBLK);
    SWAIT(); SWRITE(1, 0); __syncthreads();
#ifdef ATT_3BUF
    int bk = 1;
#define NXT(x) ((x) == 2 ? 0 : (x) + 1)
#pragma unroll 1
    for (int j = 1; j + 1 < NT; j += 2) {
        const int b1 = NXT(bk), b2 = NXT(b1);
        SBAR(); qkt64<ZI>(pB0, pB1, K_lds + bk * SHM_K, qr, r32, hi, negM);
        finishSM(pA0, pA1, l_reg, pa0, pa1, pa2, pa3); SBAR();
        SLOAD(0, (j + 1) * KVBLK); SBAR();
        pv_all<ZI>(o, vb0 + b2 * SHM_V, pa0, pa1, pa2, pa3); partialSM(pB0);
        SWAIT(); SWRITE(b1, 0);
        __syncthreads();
        SBAR(); qkt64<ZI>(pA0, pA1, K_lds + b1 * SHM_K, qr, r32, hi, negM);
        finishSM(pB0, pB1, l_reg, pa0, pa1, pa2, pa3); SBAR();
        SLOAD(0, (j + 2) * KVBLK); SBAR();
        pv_all<ZI>(o, vb0 + bk * SHM_V, pa0, pa1, pa2, pa3); partialSM(pA0);
        SWAIT(); SWRITE(b2, 0);
        __syncthreads();
        bk = b2;
    }
    { const int bp = bk == 0 ? 2 : bk - 1;
    SBAR(); qkt64<ZI>(pB0, pB1, K_lds + bk * SHM_K, qr, r32, hi, negM);
    finishSM(pA0, pA1, l_reg, pa0, pa1, pa2, pa3); SBAR();
    pv_all<ZI>(o, vb0 + bp * SHM_V, pa0, pa1, pa2, pa3); partialSM(pB0);
    finishSM(pB0, pB1, l_reg, pa0, pa1, pa2, pa3); SBAR();
    pv_all<ZI>(o, vb0 + bk * SHM_V, pa0, pa1, pa2, pa3); }
#undef NXT
#else
#pragma unroll 1
    for (int j = 1; j + 1 < NT; j += 2) {
        SBAR(); qkt64<ZI>(pB0, pB1, K_lds + SHM_K, qr, r32, hi, negM);
        finishSM(pA0, pA1, l_reg, pa0, pa1, pa2, pa3); SBAR();
        SLOAD(0, (j + 1) * KVBLK); SBAR();
        pv_all<ZI>(o, vb0, pa0, pa1, pa2, pa3); partialSM(pB0);
        __syncthreads(); SWAIT(); SWRITE(0, 0);
        __syncthreads();
        SBAR(); qkt64<ZI>(pA0, pA1, K_lds, qr, r32, hi, negM);
        finishSM(pB0, pB1, l_reg, pa0, pa1, pa2, pa3); SBAR();
        SLOAD(0, (j + 2) * KVBLK); SBAR();
        pv_all<ZI>(o, vb0 + SHM_V, pa0, pa1, pa2, pa3); partialSM(pA0);
        __syncthreads(); SWAIT(); SWRITE(1, 0);
        __syncthreads();
    }
    SBAR(); qkt64<ZI>(pB0, pB1, K_lds + SHM_K, qr, r32, hi, negM);
    finishSM(pA0, pA1, l_reg, pa0, pa1, pa2, pa3); SBAR();
    pv_all<ZI>(o, vb0, pa0, pa1, pa2, pa3); partialSM(pB0);
    finishSM(pB0, pB1, l_reg, pa0, pa1, pa2, pa3); SBAR();
    pv_all<ZI>(o, vb0 + SHM_V, pa0, pa1, pa2, pa3);
#endif
    if (hi == 0) li_l[r32] = l_reg;
    asm volatile("s_waitcnt lgkmcnt(0)" ::: "memory");
    if (sub == 0) {
#pragma unroll
        for (int gi = 0; gi < 8; ++gi) { unsigned wv[4];
#pragma unroll
            for (int c = 0; c < 4; ++c) { const int dw = gi * 4 + c, d0 = dw >> 3, i = dw & 7;
                const float rl0 = __builtin_amdgcn_rcpf(li_l[crow(2 * i, hi)]), rl1 = __builtin_amdgcn_rcpf(li_l[crow(2 * i + 1, hi)]);
                wv[c] = pk2(o[d0][2 * i] * rl0, o[d0][2 * i + 1] * rl1); }
            *(LAS v4u*)(park + gi * 1024 + lane * 16) = (v4u){wv[0], wv[1], wv[2], wv[3]}; }
    } else {
#ifdef ATT_3BUF
        int le; asm volatile("v_mbcnt_lo_u32_b32 %0, -1, 0\n\tv_mbcnt_hi_u32_b32 %0, -1, %0" : "=v"(le));
        const int lane = le, r32 = le & 31, hi = le >> 5;
#endif
        float ss[16];
#pragma unroll
        for (int r = 0; r < 16; ++r) ss[r] = 0.f;
#pragma unroll
        for (int gi = 0; gi < 8; ++gi) { const v4u pk = *(const LAS v4u*)(park + gi * 1024 + lane * 16); const unsigned wv[4] = {pk.x, pk.y, pk.z, pk.w};
#pragma unroll
            for (int c = 0; c < 4; ++c) { const int dw = gi * 4 + c, d0 = dw >> 3, i = dw & 7;
                const float rl0 = __builtin_amdgcn_rcpf(li_l[crow(2 * i, hi)]), rl1 = __builtin_amdgcn_rcpf(li_l[crow(2 * i + 1, hi)]);
                const float v0 = bflo(wv[c]) - lam * (o[d0][2 * i] * rl0), v1 = bfhi(wv[c]) - lam * (o[d0][2 * i + 1] * rl1);
                o[d0][2 * i] = v0; o[d0][2 * i + 1] = v1; ss[2 * i] += v0 * v0; ss[2 * i + 1] += v1 * v1; } }
#pragma unroll
        for (int m = 1; m < 32; m <<= 1)
#pragma unroll
            for (int r = 0; r < 16; ++r) ss[r] += __shfl_xor(ss[r], m);
        float g4[4];
#pragma unroll
        for (int d0 = 0; d0 < 4; ++d0) { int r32e = r32; asm volatile("" : "+v"(r32e)); g4[d0] = KIN(38)[d0 * 32 + r32e]; }
        asm volatile("s_waitcnt lgkmcnt(0)" ::: "memory");
#ifdef WO1_F8
#pragma unroll
        for (int r = 0; r < 16; ++r) { const float rstd = SC_A8 * rsc / sqrtf(ss[r] * (1.0f / 128.0f) + 1e-5f); const int orow = crow(r, hi);
            const unsigned w4 = pk4_fp8(o[0][r] * rstd * g4[0], o[1][r] * rstd * g4[1], o[2][r] * rstd * g4[2], o[3][r] * rstd * g4[3]);
#pragma unroll
            for (int d0 = 0; d0 < 4; ++d0) *(LAS unsigned char*)(park + orow * 128 + d0 * 32 + r32) = (unsigned char)(w4 >> (8 * d0)); }
        asm volatile("s_waitcnt lgkmcnt(0)" ::: "memory");
        unsigned char* Ow = (unsigned char*)AO + (size_t)(b * SEQ + qt * 256 + wid * 32) * D + h * 128;
#pragma unroll
        for (int i = 0; i < 4; ++i) { const int row = 8 * i + (lane >> 3), ch = lane & 7;
            *(v4u*)(Ow + (size_t)row * D + ch * 16) = *(const LAS v4u*)(park + row * 128 + ch * 16); }
#else
#pragma unroll
        for (int r = 0; r < 16; ++r) { const float rstd = rsc / sqrtf(ss[r] * (1.0f / 128.0f) + 1e-5f); const int orow = crow(r, hi);
#pragma unroll
            for (int d0 = 0; d0 < 4; ++d0) *(LAS unsigned short*)(park + orow * 256 + (d0 * 32 + r32) * 2) = f2bf(o[d0][r] * rstd * g4[d0]); }
        asm volatile("s_waitcnt lgkmcnt(0)" ::: "memory");
        bf16* Ow = AO + (size_t)(b * SEQ + qt * 256 + wid * 32) * D + h * 128;
#pragma unroll
        for (int i = 0; i < 8; ++i) { const int row = 4 * i + (lane >> 4), ch = lane & 15;
            *(v4u*)(Ow + (size_t)row * D + ch * 8) = *(const LAS v4u*)(park + row * 256 + ch * 16); }
#endif
    }
    __syncthreads();
    }
#undef SLOAD
#undef SWRITE
#undef SWAIT
}
#undef SBAR
}

__device__ __forceinline__ void attn_combine_rows(Frame& F, const bf16* OT, bf16* AO) {
    const int gw = blockIdx.x * NWAVES + F.wave, NGW = F.G * NWAVES;
    const float s1 = wave_sum(KIN(34)[F.lane] * KIN(35)[F.lane]), s2 = wave_sum(KIN(36)[F.lane] * KIN(37)[F.lane]);
    const float lam_init = 0.8f - 0.6f * expf(-0.3f), lam = expf(s1) - expf(s2) + lam_init;
    const int hd = F.lane >> 2, e0 = (F.lane & 3) * 32;
    for (int r = gw; r < RL; r += NGW) {
        const bf16* p1 = OT + (size_t)r * (2 * D) + (hd * 2) * 128 + e0; const bf16* p2 = p1 + 128;
        float o[32]; float ss = 0.f;
#pragma unroll
        for (int k = 0; k < 4; ++k) { float a[8], b[8]; unpack8(*(const v4u*)(p1 + 8 * k), a); unpack8(*(const v4u*)(p2 + 8 * k), b);
#pragma unroll
            for (int e = 0; e < 8; ++e) { const float v = a[e] - lam * b[e]; o[8 * k + e] = v; ss += v * v; } }
        ss += __shfl_xor(ss, 1); ss += __shfl_xor(ss, 2);
        const float rstd = (1.0f - lam_init) / sqrtf(ss * (1.0f / 128.0f) + 1e-5f);
#pragma unroll
        for (int k = 0; k < 4; ++k) { float f[8];
#pragma unroll
            for (int e = 0; e < 8; ++e) f[e] = o[8 * k + e] * rstd * KIN(38)[e0 + 8 * k + e];
            *(v4u*)(AO + (size_t)r * D + hd * 128 + e0 + 8 * k) = pack8(f); }
    }
}

constexpr int LDS_MOE_OFF = 132 * 1024;
__device__ __forceinline__ void moe_route_rows(Frame& F, const float* x, const float* g, const float* modl, unsigned char* A4) {
    LAS float* rt = (LAS float*)F.lds;
    LAS int* sel = (LAS int*)(F.lds + 64 * 1024);
    for (int i = F.tid; i < 2048 * 8; i += 512) { const int k = i >> 3, e = i & 7; rt[e * 2048 + k] = KIN(40)[i]; }
    __syncthreads();
    int* TOPI = (int*)(F.ws + WS_ROUTE + RO_TOPI); float* TOPG = (float*)(F.ws + WS_ROUTE + RO_TOPG); int* LRANK = (int*)(F.ws + WS_ROUTE + RO_LRANK); int* CNT = (int*)(F.ws + WS_ROUTE + RO_CNT);
    for (int ub = blockIdx.x; ub < RL / 64; ub += F.G) {
        const int rb = ub * 64 + 8 * F.wave, mrow = rb >> 11;
        LAS float* gml = (LAS float*)(F.lds + 72 * 1024); LAS float* hml = (LAS float*)(F.lds + 80 * 1024);
        { const f32x4* sh = (const f32x4*)(modl + (size_t)mrow * 12288 + 3 * 2048); const f32x4* sc = (const f32x4*)(modl + (size_t)mrow * 12288 + 4 * 2048);
          *(LAS f32x4*)(gml + 4 * F.tid) = ((const f32x4*)g)[F.tid] * (sc[F.tid] + 1.0f); *(LAS f32x4*)(hml + 4 * F.tid) = sh[F.tid]; }
        __syncthreads();
#define MR_LOAD(v, r_) do { const f32x4* s_ = (const f32x4*)(x + (size_t)(r_) * D); _Pragma("unroll") for (int q = 0; q < 8; ++q) v[q] = s_[F.lane + 64 * q]; asm volatile("" ::: "memory"); __builtin_amdgcn_sched_barrier(0); } while (0)
#define MR_ROW(v, r_) do { const int r = (r_), lr = r - ub * 64; float ss = 0.f;                                                                              \
            _Pragma("unroll") for (int q = 0; q < 8; ++q) ss += (v[q].x * v[q].x + v[q].y * v[q].y) + (v[q].z * v[q].z + v[q].w * v[q].w);                       \
            const float rstd = 1.0f / sqrtf(wave_sum(ss) * (1.0f / D) + 1e-6f);                                                                                 \
            float lg[8];                                                                                                                                       \
            _Pragma("unroll") for (int e = 0; e < 8; ++e) lg[e] = 0.f;                                                                                          \
            unsigned* o8 = (unsigned*)(A4 + (size_t)r * D);                                                                                                     \
            _Pragma("unroll") for (int q = 0; q < 8; ++q) { const int c4 = F.lane + 64 * q;                                                                     \
                const f32x4 y = v[q] * rstd * *(const LAS f32x4*)(gml + 4 * c4) + *(const LAS f32x4*)(hml + 4 * c4); o8[c4] = pk4_fp8(y.x * SC_A8, y.y * SC_A8, y.z * SC_A8, y.w * SC_A8);                              \
                _Pragma("unroll") for (int e = 0; e < 8; ++e) { const f32x4 rv = *(const LAS f32x4*)(rt + e * 2048 + 4 * c4); lg[e] += (y.x * rv.x + y.y * rv.y) + (y.z * rv.z + y.w * rv.w); } } \
            _Pragma("unroll") for (int e = 0; e < 8; ++e) lg[e] = wave_sum(lg[e]);                                                                              \
            int i1 = 0; float l1 = lg[0];                                                                                                                      \
            _Pragma("unroll") for (int e = 1; e < 8; ++e) if (lg[e] > l1) { l1 = lg[e]; i1 = e; }                                                               \
            int i2 = -1; float l2 = -3.0e38f;                                                                                                                  \
            _Pragma("unroll") for (int e = 0; e < 8; ++e) if (e != i1 && lg[e] > l2) { l2 = lg[e]; i2 = e; }                                                    \
            if (F.lane == 0) { const float g2 = 1.0f / (1.0f + expf(l1 - l2)); TOPI[2 * r] = i1; TOPI[2 * r + 1] = i2; TOPG[2 * r] = 1.0f - g2; TOPG[2 * r + 1] = g2; sel[2 * lr] = i1; sel[2 * lr + 1] = i2; } \
            asm volatile("" ::: "memory"); __builtin_amdgcn_sched_barrier(0); } while (0)
        f32x4 va[8], vb[8];
        MR_LOAD(va, rb);
        __builtin_amdgcn_s_waitcnt(0x0F70);
#pragma unroll 1
        for (int j = 0; j < 8; j += 2) {
            __builtin_amdgcn_s_waitcnt(0x0F78);
            MR_LOAD(vb, rb + j + 1);
            MR_ROW(va, rb + j);
            __builtin_amdgcn_s_waitcnt(0x0F78);
            if (j + 2 < 8) MR_LOAD(va, rb + j + 2);
            MR_ROW(vb, rb + j + 1);
        }
#undef MR_LOAD
#undef MR_ROW
        __syncthreads();
        if (F.wave == 0) {
            const int s0 = sel[2 * F.lane], s1 = sel[2 * F.lane + 1]; const unsigned long long lt = (1ull << F.lane) - 1ull; int rk0 = 0, rk1 = 0;
#pragma unroll
            for (int e = 0; e < 8; ++e) { const unsigned long long m0 = __ballot(s0 == e), m1 = __ballot(s1 == e); const int before = __popcll(m0 & lt) + __popcll(m1 & lt);
                if (s0 == e) rk0 = before; if (s1 == e) rk1 = before;
                if (F.lane == 0) CNT[ub * 8 + e] = __popcll(m0) + __popcll(m1); }
            LRANK[2 * (ub * 64 + F.lane)] = rk0; LRANK[2 * (ub * 64 + F.lane) + 1] = rk1;
        }
        __syncthreads();
    }
}
__device__ __forceinline__ int wave_sum_i(int v) {
#pragma unroll
    for (int m = 1; m < 64; m <<= 1) v += __shfl_xor(v, m);
    return v;
}
__device__ __forceinline__ void moe_layout(Frame& F, int ub) {
    LAS int* L = (LAS int*)(F.lds + LDS_MOE_OFF);
    LAS int* part = L + 512;
    const int* CNT = (const int*)(F.ws + WS_ROUTE + RO_CNT);
    if (F.wave < RL / 64 / 64) {
        int tv[8], pv[8];
#pragma unroll
        for (int e = 0; e < 8; ++e) { const int c = CNT[F.tid * 8 + e]; tv[e] = c; pv[e] = F.tid < ub ? c : 0; }
#pragma unroll
        for (int e = 0; e < 8; ++e) { tv[e] = wave_sum_i(tv[e]); pv[e] = wave_sum_i(pv[e]); }
        if (F.lane == 0) {
#pragma unroll
            for (int e = 0; e < 8; ++e) { part[F.wave * 16 + e] = tv[e]; part[F.wave * 16 + 8 + e] = pv[e]; } }
    }
    __syncthreads();
    if (F.tid < 16) { int sacc = 0;
#pragma unroll
        for (int w = 0; w < RL / 64 / 64; ++w) sacc += part[w * 16 + F.tid];
        L[F.tid < 8 ? F.tid : 24 + (F.tid - 8)] = sacc; }
    __syncthreads();
    if (F.tid == 0) { int row = 0, np = 0;
        for (int e = 0; e < 8; ++e) { L[8 + e] = row; const int pe = (L[e] + 255) >> 8; for (int p = 0; p < pe; ++p) L[32 + np + p] = e; np += pe; row += pe * 256; }
        L[16] = np; }
    __syncthreads();
}
__device__ __forceinline__ void moe_gather(Frame& F, const unsigned char* A4, unsigned char* AG) {
    LAS int* L = (LAS int*)(F.lds + LDS_MOE_OFF);
    const int* TOPI = (const int*)(F.ws + WS_ROUTE + RO_TOPI); const int* LRANK = (const int*)(F.ws + WS_ROUTE + RO_LRANK); int* ROWOF = (int*)(F.ws + WS_ROUTE + RO_ROWOF);
    for (int ub = blockIdx.x; ub < RL / 64; ub += F.G) {
        moe_layout(F, ub);
        {
            const int rbase = ub * 64 + 8 * F.wave; int dest = 0;
            if (F.lane < 16) { const int e = TOPI[2 * rbase + F.lane]; dest = L[8 + e] + L[24 + e] + LRANK[2 * rbase + F.lane]; ROWOF[2 * rbase + F.lane] = dest; }
            v4u v[8][2];
#pragma unroll
            for (int k = 0; k < 8; ++k) { const v4u* sp = (const v4u*)(A4 + (size_t)(rbase + k) * D); v[k][0] = sp[F.lane]; v[k][1] = sp[F.lane + 64]; }
#pragma unroll
            for (int k = 0; k < 8; ++k) { const int d1 = __builtin_amdgcn_readlane(dest, 2 * k), d2 = __builtin_amdgcn_readlane(dest, 2 * k + 1);
                v4u* p1 = (v4u*)(AG + (size_t)d1 * D); v4u* p2 = (v4u*)(AG + (size_t)d2 * D);
                p1[F.lane] = v[k][0]; p1[F.lane + 64] = v[k][1]; p2[F.lane] = v[k][0]; p2[F.lane + 64] = v[k][1]; }
        }
        __syncthreads();
    }
    if (blockIdx.x < 8) {
        moe_layout(F, -1);
        const int e = blockIdx.x, n = L[e], r0 = L[8 + e] + n, r1 = L[8 + e] + ((n + 255) >> 8) * 256;
        for (int r = r0 + F.wave; r < r1; r += NWAVES) { v4u* dp = (v4u*)(AG + (size_t)r * D);
#pragma unroll
            for (int q = 0; q < 2; ++q) dp[F.lane + 64 * q] = (v4u){0u, 0u, 0u, 0u}; }
    }
}
__device__ __forceinline__ void moe_combine_rows(Frame& F, float* x, const float* modl, const bf16* Y) {
    const int gw = __builtin_amdgcn_readfirstlane(blockIdx.x * NWAVES + F.wave), NGW = F.G * NWAVES;
    const float* TOPG = (const float*)(F.ws + WS_ROUTE + RO_TOPG); const int* ROWOF = (const int*)(F.ws + WS_ROUTE + RO_ROWOF);
    const int per = (RL + NGW - 1) / NGW, r0 = gw * per, r1 = min(RL, r0 + per);
#define MC_LOAD(Y1, Y2, X, r_) do { const int li = 2 * ((r_) - c0); const int d1 = __builtin_amdgcn_readlane(rov, li), d2 = __builtin_amdgcn_readlane(rov, li + 1);           \
        const v4u* p1 = (const v4u*)(Y + (size_t)d1 * D); const v4u* p2 = (const v4u*)(Y + (size_t)d2 * D); const f32x4* xp = (const f32x4*)(x + (size_t)(r_) * D);           \
        _Pragma("unroll") for (int q = 0; q < 4; ++q) { const int c8 = F.lane + 64 * q; Y1[q] = p1[c8]; Y2[q] = p2[c8]; X[2 * q] = xp[2 * c8]; X[2 * q + 1] = xp[2 * c8 + 1]; }   \
        asm volatile("" ::: "memory"); __builtin_amdgcn_sched_barrier(0); } while (0)
#define MC_ROW(Y1, Y2, X, r_) do { const int li = 2 * ((r_) - c0); const float g1 = __builtin_bit_cast(float, __builtin_amdgcn_readlane(__builtin_bit_cast(int, tgv), li)), g2 = __builtin_bit_cast(float, __builtin_amdgcn_readlane(__builtin_bit_cast(int, tgv), li + 1)); \
        f32x4* xp = (f32x4*)(x + (size_t)(r_) * D);                                                                                                                        \
        _Pragma("unroll") for (int q = 0; q < 4; ++q) { const int c8 = F.lane + 64 * q; float a[8], b[8]; unpack8(Y1[q], a); unpack8(Y2[q], b);                             \
            const f32x4 m0 = {a[0] * g1 + b[0] * g2, a[1] * g1 + b[1] * g2, a[2] * g1 + b[2] * g2, a[3] * g1 + b[3] * g2}, m1 = {a[4] * g1 + b[4] * g2, a[5] * g1 + b[5] * g2, a[6] * g1 + b[6] * g2, a[7] * g1 + b[7] * g2}; \
            xp[2 * c8] = X[2 * q] + gm[2 * q] * m0; xp[2 * c8 + 1] = X[2 * q + 1] + gm[2 * q + 1] * m1; }                                                                    \
        asm volatile("" ::: "memory"); __builtin_amdgcn_sched_barrier(0); } while (0)
    for (int c0 = r0; c0 < r1; c0 += 32) {
        const int cn = min(32, r1 - c0);
        int rov = 0; float tgv = 0.f;
        if (F.lane < 2 * cn) { rov = ROWOF[2 * c0 + F.lane]; tgv = TOPG[2 * c0 + F.lane]; }
        for (int s0 = c0; s0 < c0 + cn;) {
            const int bat = s0 >> 11, send = min(c0 + cn, (bat + 1) << 11);
            f32x4 gm[8];
            { const f32x4* gp = (const f32x4*)(modl + (size_t)bat * 12288 + 5 * 2048);
#pragma unroll
              for (int q = 0; q < 4; ++q) { const int c8 = F.lane + 64 * q; gm[2 * q] = gp[2 * c8]; gm[2 * q + 1] = gp[2 * c8 + 1]; } }
            __builtin_amdgcn_s_waitcnt(0x0F70);
            v4u ya1[4], ya2[4], yb1[4], yb2[4]; f32x4 xa[8], xb[8];
            MC_LOAD(ya1, ya2, xa, s0);
            __builtin_amdgcn_s_waitcnt(0x0F70);
#pragma unroll 1
            for (int r = s0; r < send; r += 2) {
                __builtin_amdgcn_s_waitcnt(0x0F78);
                if (r + 1 < send) MC_LOAD(yb1, yb2, xb, r + 1);
                MC_ROW(ya1, ya2, xa, r);
                if (r + 1 < send) { __builtin_amdgcn_s_waitcnt(0x0F78); if (r + 2 < send) MC_LOAD(ya1, ya2, xa, r + 2); MC_ROW(yb1, yb2, xb, r + 1); }
            }
            __builtin_amdgcn_s_waitcnt(0x0F70);
            s0 = send;
        }
    }
#undef MC_LOAD
#undef MC_ROW
}

struct Args { const float* in[44]; float* out; unsigned char* ws; unsigned long long mask; };
__global__ void __launch_bounds__(NWAVES * 64, 2) fwd(Args args) {
    extern __shared__ __attribute__((aligned(16))) unsigned char lds[];
    Frame F;
    F.lds = (LAS unsigned char*)lds;
    F.MISC = (volatile LAS unsigned*)(F.lds + MISC_OFF);
    F.tid = threadIdx.x; F.lane = F.tid & 63; F.wave = __builtin_amdgcn_readfirstlane(F.tid >> 6);
    F.G = gridDim.x; F.out = args.out; F.ws = args.ws;
    F.ctl = (unsigned*)(F.ws + WS_CTL);
    for (int u = F.tid; u < 256; u += NWAVES * 64) ((LAS unsigned*)(F.lds + MISC_OFF))[u] = 0u;
    __syncthreads();
    XcdBarrier bar = xcd_barrier_post(F.ctl + CW_BAR, F.MISC + 8);
    const unsigned long long mask = args.mask;
#define RUN(p) ((mask >> (p)) & 1ull)
#define GRID_BAR() xcd_barrier(bar)
#define PH_BEGIN() do { int l_; asm volatile("v_mbcnt_lo_u32_b32 %0, -1, 0\n\tv_mbcnt_hi_u32_b32 %0, -1, %0" : "=v"(l_)); F.lane = l_; F.tid = F.wave * 64 + l_; __builtin_amdgcn_s_waitcnt(0x0F70); } while (0)
#ifndef PROBE_REP
#define PROBE_REP (-1)
#endif
#define PHASE(p) if (RUN(p)) for (int rep_ = 0; rep_ < (PROBE_REP == (p) ? 2 : 1); ++rep_)
#define MOD0 WSP(float, WS_MOD)
#define MOD1 (WSP(float, WS_MOD) + 9 * 12288)
#define XC WSP(float, WS_XC)
#define ACTA WSP(bf16, WS_ACTA)
#define ACTB WSP(bf16, WS_ACTB)
#define ACTC WSP(bf16, WS_ACTC)

    if (RUN(0)) { PH_BEGIN(); p0_ada(F); __syncthreads(); p0_rope_table(F); p0_transposes(F); GRID_BAR(); }

    if (RUN(21)) { PH_BEGIN(); copy_rows(F, KIN(0), F.out, (size_t)RL * D / 4); copy_rows(F, KIN(2), XC, (size_t)RC * D / 4); GRID_BAR(); }

#ifdef IN_F8
    PHASE(1) { PH_BEGIN(); norm_mod_rows<true>(F, KIN(0), KIN(2), KIN(6), MOD0, 0, 1, ACTA, RT); GRID_BAR(); }
#else
    PHASE(1) { PH_BEGIN(); norm_mod_rows(F, KIN(0), KIN(2), KIN(6), MOD0, 0, 1, ACTA, RT); GRID_BAR(); }
#endif
    PHASE(2) { PH_BEGIN();
#ifdef IN_F8
        pg8::Gemm g{ACTA, WSP(bf16, W_WIN), RT, NINP, D / 2}; pg8::StaticOrder S; S.init(RT, NINP, F.G, (int)blockIdx.x);
        pg8::EpiBf16G E{ACTB, NINP, 8, 1.0f / (SC_A8 * SC_W13)};
        pg8::gemm_phase<pg8::EpiBf16G, pg8::StaticOrder, true, true, true>(F.lds + RING_OFF, g, S, E, F.wave);
#else
        pg8::Gemm g{ACTA, WSP(bf16, W_WIN), RT, NINP, D}; pg8::StaticOrder S; S.init(RT, NINP, F.G, (int)blockIdx.x);
        pg8::EpiBf16G E{ACTB, NINP, 8};
        pg8::gemm_phase<pg8::EpiBf16G, pg8::StaticOrder, true, true>(F.lds + RING_OFF, g, S, E, F.wave);
#endif
        fill_tail(F, 0, (RT / 256) * (NINP / 256));
        GRID_BAR();
    }
    if (RUN(3)) { PH_BEGIN();
        for (;;) {
            if (F.tid == 0) F.MISC[16] = __hip_atomic_fetch_add(F.ctl + CW_Q3, 1u, __ATOMIC_RELAXED, __HIP_MEMORY_SCOPE_AGENT);
            __syncthreads();
            const int it = (int)F.MISC[16];
            __syncthreads();
            if (it >= RT / FT + 1152) break;
            if (it < RT / FT) { if (RUN(22)) feat_unit(F, it, ACTB, ACTA); } else sgu_unit(F, it - RT / FT, ACTB, ACTA);
        }
        if (!RUN(22)) zero_ab_right(F, ACTA);
        GRID_BAR();
    }
    if (RUN(4)) { PH_BEGIN();
#ifdef SCANP_REP
#pragma unroll 1
        for (int rep = 0; rep < SCANP_REP; ++rep)
#endif
        for (int u = blockIdx.x; u < 256; u += F.G) sc2::scan_unit2(F, u); GRID_BAR(); }
    PHASE(5) { PH_BEGIN(); readout_rows(F, ACTA); GRID_BAR(); }
    PHASE(6) { PH_BEGIN();
#ifdef WO0_F8
        pg8::Gemm g{ACTA, WSP(bf16, W_WO0), RT, D, D, D / 128}; pg8::StaticOrder S; S.init(RT, D, F.G, (int)blockIdx.x);
        pg8::EpiResGate E{KIN(0), KIN(2), F.out, XC, MOD0 + 2 * 2048, 1.0f / (SC_A8 * SC_W13)};
        pg8::gemm_phase<pg8::EpiResGate, pg8::StaticOrder, true, true, true>(F.lds + RING_OFF, g, S, E, F.wave);
#else
        pg8::Gemm g{ACTA, WSP(bf16, W_WO0), RT, D, D}; pg8::StaticOrder S; S.init(RT, D, F.G, (int)blockIdx.x);
        pg8::EpiResGate E{KIN(0), KIN(2), F.out, XC, MOD0 + 2 * 2048, 1.0f};
        pg8::gemm_phase<pg8::EpiResGate, pg8::StaticOrder, true, true>(F.lds + RING_OFF, g, S, E, F.wave);
#endif
        fill_tail(F, 1, (RT / 256) * (D / 256));
        GRID_BAR();
    }
#ifdef F13_F8
    PHASE(7) { PH_BEGIN(); norm_mod_rows<true>(F, F.out, XC, KIN(7), MOD0, 3, 4, ACTA, RT); GRID_BAR(); }
#else
    PHASE(7) { PH_BEGIN(); norm_mod_rows(F, F.out, XC, KIN(7), MOD0, 3, 4, ACTA, RT); GRID_BAR(); }
#endif
    PHASE(8) { PH_BEGIN();
#ifdef F13_F8
        pg8::Gemm g{ACTA, WSP(bf16, W_W13), RT, 2 * FF, D / 2}; pg8::StaticOrder S; S.init(RT, 2 * FF, F.G, (int)blockIdx.x);
#ifdef F2_BF16
        pg8::EpiSwiGLU E{ACTB, FF, 1.0f / (SC_A8 * SC_W13)};
        pg8::gemm_phase<pg8::EpiSwiGLU, pg8::StaticOrder, true, true, true>(F.lds + RING_OFF, g, S, E, F.wave);
#else
        pg8::EpiSwiGLU8 E{(unsigned char*)ACTB, FF, 1.0f / (SC_A8 * SC_W13)};
        pg8::gemm_phase<pg8::EpiSwiGLU8, pg8::StaticOrder, true, true, true>(F.lds + RING_OFF, g, S, E, F.wave);
#endif
#else
        pg8::Gemm g{ACTA, WSP(bf16, W_W13), RT, 2 * FF, D}; pg8::StaticOrder S; S.init(RT, 2 * FF, F.G, (int)blockIdx.x);
        pg8::EpiSwiGLU8 E{(unsigned char*)ACTB, FF, 1.0f};
        pg8::gemm_phase<pg8::EpiSwiGLU8, pg8::StaticOrder, true, true>(F.lds + RING_OFF, g, S, E, F.wave);
#endif
        fill_tail(F, 2, (RT / 256) * (2 * FF / 256));
        GRID_BAR();
    }
#if defined(PROBE_DRAIN) && defined(PROBE_DRAIN_AT9)
    if (blockIdx.x == 0 && F.tid == 0) { unsigned done = 0; for (int sh = 0; sh < 8; ++sh) { const unsigned q = __hip_atomic_load(F.ctl + CW_CQ + 64 * sh, __ATOMIC_RELAXED, __HIP_MEMORY_SCOPE_AGENT); done += q < (unsigned)(TI_NQ / 8) ? q : (unsigned)(TI_NQ / 8); }
        ((float*)(F.ctl + 2048))[0] = 1.0f - (float)done / (float)TI_NQ; }
#endif
    if (RUN(9)) { PH_BEGIN();
#ifdef F2_BF16
        pg8::Gemm g{ACTB, WSP(bf16, W_W2), RT, D, FF}; pg8::StaticOrder S; S.init(RT, D, F.G, (int)blockIdx.x);
        pg8::EpiResGate E{F.out, XC, F.out, XC, MOD0 + 5 * 2048, 1.0f};
        pg8::gemm_phase<pg8::EpiResGate, pg8::StaticOrder, true, true>(F.lds + RING_OFF, g, S, E, F.wave);
#else
        pg8::Gemm g{ACTB, WSP(bf16, W_W2), RT, D, FF / 2}; pg8::StaticOrder S; S.init(RT, D, F.G, (int)blockIdx.x);
        pg8::EpiResGate E{F.out, XC, F.out, XC, MOD0 + 5 * 2048, 1.0f / (SC_H8 * SC_W2)};
        pg8::gemm_phase<pg8::EpiResGate, pg8::StaticOrder, true, true, true>(F.lds + RING_OFF, g, S, E, F.wave);
#endif
        fill_tail(F, 3, (RT / 256) * (D / 256));
        GRID_BAR();
    }
#ifdef QKV_F8
    PHASE(10) { PH_BEGIN(); norm_mod_rows<true>(F, F.out, XC, KIN(29), MOD1, 0, 1, ACTA, RT); GRID_BAR(); }
#else
    PHASE(10) { PH_BEGIN(); norm_mod_rows(F, F.out, XC, KIN(29), MOD1, 0, 1, ACTA, RT); GRID_BAR(); }
#endif
#ifdef PROBE_NORM2
    { PH_BEGIN(); norm_mod_rows(F, KIN(0), KIN(2), KIN(29), MOD1, 0, 1, ACTC, RT); GRID_BAR(); }
#endif
    PHASE(11) { PH_BEGIN();
#ifdef QKV_F8
        pg8::Gemm g{ACTA, WSP(bf16, W_QKV), RT, 3 * D, D / 2}; pg8::StaticOrder S; S.init(RT, 3 * D, F.G, (int)blockIdx.x);
        pg8::EpiBf16S E{ACTB, 3 * D, 1.0f / (SC_A8 * SC_W13)};
        pg8::gemm_phase<pg8::EpiBf16S, pg8::StaticOrder, true, true, true>(F.lds + RING_OFF, g, S, E, F.wave);
#else
        pg8::Gemm g{ACTA, WSP(bf16, W_QKV), RT, 3 * D, D}; pg8::StaticOrder S; S.init(RT, 3 * D, F.G, (int)blockIdx.x);
        pg8::EpiBf16G E{ACTB, 3 * D, 0};
        pg8::gemm_phase<pg8::EpiBf16G, pg8::StaticOrder, true, true>(F.lds + RING_OFF, g, S, E, F.wave);
#endif
        fill_tail(F, 4, (RT / 256) * (3 * D / 256));
        GRID_BAR();
    }
    PHASE(12) { PH_BEGIN(); qknorm_rope_rows(F, ACTB); GRID_BAR(); }
    PHASE(13) { PH_BEGIN();
        float gq = fabsf(KIN(32)[F.lane]), gk = fabsf(KIN(33)[F.lane]);
#pragma unroll
        for (int o = 1; o < 64; o <<= 1) { gq = fmaxf(gq, __shfl_xor(gq, o)); gk = fmaxf(gk, __shfl_xor(gk, o)); }
        const float negM = -(8.0f * gq * gk * 1.4426950408889634f * 1.02f);
        const float s1 = wave_sum(KIN(34)[F.lane] * KIN(35)[F.lane]), s2 = wave_sum(KIN(36)[F.lane] * KIN(37)[F.lane]);
        const float lam_init = 0.8f - 0.6f * expf(-0.3f), lam = expf(s1) - expf(s2) + lam_init;
        if (negM > -96.0f) { for (int u = blockIdx.x; u < 1024; u += F.G) att::attn_unit<true>(F, u, ACTB, ACTA, negM, lam, 1.0f - lam_init); }
        else { for (int u = blockIdx.x; u < 1024; u += F.G) att::attn_unit<false>(F, u, ACTB, ACTA, negM, lam, 1.0f - lam_init); }
        GRID_BAR();
    }
    PHASE(15) { PH_BEGIN();
#ifdef WO1_F8
        pg8::Gemm g{ACTA, WSP(bf16, W_WO1), RL, D, D / 2}; pg8::StaticOrder S; S.init(RL, D, F.G, (int)blockIdx.x);
        pg8::EpiResGate E{F.out, nullptr, F.out, nullptr, MOD1 + 2 * 2048, 1.0f / (SC_A8 * SC_W13)};
        pg8::gemm_phase<pg8::EpiResGate, pg8::StaticOrder, true, true, true>(F.lds + RING_OFF, g, S, E, F.wave);
#else
        pg8::Gemm g{ACTA, WSP(bf16, W_WO1), RL, D, D}; pg8::StaticOrder S; S.init(RL, D, F.G, (int)blockIdx.x);
        pg8::EpiResGate E{F.out, nullptr, F.out, nullptr, MOD1 + 2 * 2048, 1.0f};
        pg8::gemm_phase<pg8::EpiResGate, pg8::StaticOrder, true, true>(F.lds + RING_OFF, g, S, E, F.wave);
#endif
        GRID_BAR();
    }
    PHASE(16) { PH_BEGIN(); moe_route_rows(F, F.out, KIN(30), MOD1, (unsigned char*)ACTA); GRID_BAR(); }
    if (RUN(17)) { PH_BEGIN(); moe_gather(F, (const unsigned char*)ACTA, (unsigned char*)ACTB); __syncthreads(); convert_queue(F, 0, 0u); GRID_BAR(); }
    PHASE(18) { PH_BEGIN();
        moe_layout(F, -1); LAS int* L = (LAS int*)(F.lds + LDS_MOE_OFF);
        pg8::Gemm g{ACTB, WSP(bf16, W_E13), 0, 0, D / 2}; pg8::GroupedOrder S; S.init(L[16], 2 * DE, F.G, (int)blockIdx.x, L + 32);
        pg8::EpiSwiGLU8 E{(unsigned char*)ACTC, DE, 1.0f / (SC_A8 * SC_W13)};
        pg8::gemm_phase<pg8::EpiSwiGLU8, pg8::GroupedOrder, true, true, true>(F.lds + RING_OFF, g, S, E, F.wave);
        GRID_BAR();
    }
    PHASE(19) { PH_BEGIN();
        moe_layout(F, -1); LAS int* L = (LAS int*)(F.lds + LDS_MOE_OFF);
        pg8::Gemm g{ACTC, WSP(bf16, W_E2), 0, 0, DE / 2}; pg8::GroupedOrder S; S.init(L[16], D, F.G, (int)blockIdx.x, L + 32);
        pg8::EpiBf16S E{WSP(bf16, WS_Y), D, 1.0f / (SC_H8 * SC_W2)};
#ifdef MOE_TAIL_SPLITK
        constexpr int SPL = 4; const int rem = S.nwg % F.G;
        if (rem > 0 && rem * SPL <= F.G) {
            S.lim = S.nwg - rem;
            pg8::gemm_phase<pg8::EpiBf16S, pg8::GroupedOrder, true, true, true>(F.lds + RING_OFF, g, S, E, F.wave);
            pg8::TailOrder T; T.base = S; T.L0 = S.nwg - rem; T.S = SPL; T.kslice = DE / SPL;
            pg8::Gemm g2 = g; g2.nt = (DE / 128) / SPL;
            pg8::EpiSplitK E2{(float*)ACTB};
            __syncthreads();
            pg8::gemm_phase<pg8::EpiSplitK, pg8::TailOrder, true, true, true>(F.lds + RING_OFF, g2, T, E2, F.wave);
            GRID_BAR();
            for (int t = blockIdx.x; t < rem; t += F.G) {
                pg8::Unit u; S.map(S.nwg - rem + t, u); const float* P0 = (const float*)ACTB + (size_t)(t * SPL) * 65536; const float sc = 1.0f / (SC_H8 * SC_W2);
                for (int i = F.tid; i < 65536 / 8; i += 512) { const int lr = i >> 5, lc = (i & 31) * 8; const float* p = P0 + (size_t)lr * 256 + lc;
                    f32x4 v0 = *(const f32x4*)p, v1 = *(const f32x4*)(p + 4);
#pragma unroll
                    for (int k = 1; k < SPL; ++k) { v0 = v0 + *(const f32x4*)(p + (size_t)k * 65536); v1 = v1 + *(const f32x4*)(p + (size_t)k * 65536 + 4); }
                    v0 = v0 * sc; v1 = v1 * sc;
                    v4u w; w.x = pk2(v0[0], v0[1]); w.y = pk2(v0[2], v0[3]); w.z = pk2(v1[0], v1[1]); w.w = pk2(v1[2], v1[3]);
                    *(v4u*)(WSP(bf16, WS_Y) + (size_t)(u.pm * 256 + lr) * D + u.pn * 256 + lc) = w; }
            }
        } else
#endif
        pg8::gemm_phase<pg8::EpiBf16S, pg8::GroupedOrder, true, true, true>(F.lds + RING_OFF, g, S, E, F.wave);
        GRID_BAR();
    }
    if (RUN(20)) { PH_BEGIN(); moe_combine_rows(F, F.out, MOD1, WSP(bf16, WS_Y));
#ifdef PROBE_DRAIN
        GRID_BAR(); { const float sc = 1.0f + PROBE_DRAIN * ((const float*)(F.ctl + 2048))[0]; for (size_t i = (size_t)blockIdx.x * 512 + F.tid; i < (size_t)RL * D; i += (size_t)F.G * 512) F.out[i] *= sc; }
#endif
    }
#undef RUN
#undef GRID_BAR
}

extern "C" void kernel_launch(void* const* d_in, const int* in_sizes, int n_in, void* d_out, int out_size, void* d_ws, size_t ws_size, hipStream_t stream) {
    static int grid = 0;
    if (grid == 0) {
        if (n_in != 44 || in_sizes[0] != RL * D || out_size != RL * D || ws_size < WS_END) {
            fprintf(stderr, "kernel_launch: shape mismatch: n_in %d in0 %d out %d ws %zu (need %zu)\n", n_in, n_in > 0 ? in_sizes[0] : -1, out_size, ws_size, (size_t)WS_END); grid = -1; return; }
        int dev = 0, cus = 0, per_cu = 0;
        if (hipGetDevice(&dev) != hipSuccess || hipDeviceGetAttribute(&cus, hipDeviceAttributeMultiprocessorCount, dev) != hipSuccess) { grid = -1; return; }
        if (hipFuncSetAttribute((const void*)fwd, hipFuncAttributeMaxDynamicSharedMemorySize, LDS_BYTES) != hipSuccess) { fprintf(stderr, "kernel_launch: hipFuncSetAttribute failed\n"); grid = -1; return; }
        if (hipOccupancyMaxActiveBlocksPerMultiprocessor(&per_cu, (const void*)fwd, NWAVES * 64, LDS_BYTES) != hipSuccess || per_cu < 1) { fprintf(stderr, "kernel_launch: occupancy query says %d\n", per_cu); }
        (void)hipGetLastError();
        grid = cus;
    }
    if (grid < 0) return;
    if (hipMemsetAsync((char*)d_ws + WS_CTL, 0, CTL_ZERO_BYTES, stream) != hipSuccess) return;
    Args a{};
    for (int i = 0; i < 44; ++i) a.in[i] = (const float*)d_in[i];
    a.out = (float*)d_out; a.ws = (unsigned char*)d_ws; a.mask = PHASE_MASK;
    hipLaunchKernelGGL(fwd, dim3(grid), dim3(NWAVES * 64), LDS_BYTES, stream, a);
    const hipError_t le = hipPeekAtLastError();
    if (le != hipSuccess) fprintf(stderr, "kernel_launch: launch failed: %s\n", hipGetErrorName(le));
}
```
